# Optimizing an MI355X kernel written in HIP

```python
import jax, jax.numpy as jnp
from jax import lax
import numpy as np

D_MODEL = 2048
BATCH = 4
SEQ = 4096
DEPTH = 2

N_META = 16
N_MIXERS = 2
N_HEADS = 16
HEAD_DIM = D_MODEL // N_HEADS
ATTN_WIDTH = N_HEADS * HEAD_DIM
FOX_IN_COLS = 4 * ATTN_WIDTH + N_HEADS
Q_BLOCK = 128
POOL_WINDOWS = (2, 4, 8, 16)
N_POOL_GROUPS = len(POOL_WINDOWS)
POOL_WIDTH = D_MODEL
POOL_GROUP = POOL_WIDTH // N_POOL_GROUPS
POOL_IN_COLS = 2 * POOL_WIDTH
ALPHA = (2.0 * DEPTH) ** 0.25
BETA = (8.0 * DEPTH) ** -0.25
LN_EPS = 1e-5

kernel_name = "fox_pool_interleaved_deepnorm"


def layer_norm(x, g, b):
    xf = x.astype(jnp.float32)
    mu = jnp.mean(xf, axis=-1, keepdims=True)
    var = jnp.mean(jnp.square(xf - mu), axis=-1, keepdims=True)
    y = (xf - mu) * lax.rsqrt(var + LN_EPS)
    return (y * g.astype(jnp.float32) + b.astype(jnp.float32)).astype(x.dtype)


def _fox_attend(q_blk, c_q, q_pos, k, v, c_k, k_pos):
    s = jnp.einsum('bhqd,bhkd->bhqk', q_blk, k).astype(jnp.float32) * (HEAD_DIM ** -0.5)
    s = s + c_q[..., :, None] - c_k[..., None, :]
    mask = k_pos[None, :] <= q_pos[:, None]
    s = jnp.where(mask[None, None], s, -jnp.inf)
    p = jax.nn.softmax(s, axis=-1)
    return jnp.einsum('bhqk,bhkd->bhqd', p.astype(v.dtype), v)


def fox_mixer(h, w_in, b_f, w_out):
    B, L, _ = h.shape
    proj = h @ w_in
    q, k, v, z, f = jnp.split(proj, [ATTN_WIDTH, 2 * ATTN_WIDTH, 3 * ATTN_WIDTH, 4 * ATTN_WIDTH], axis=-1)
    to_heads = lambda t: t.reshape(B, L, N_HEADS, HEAD_DIM).transpose(0, 2, 1, 3)
    q, k, v = to_heads(q), to_heads(k), to_heads(v)
    log_f = jax.nn.log_sigmoid(f.astype(jnp.float32) + b_f.astype(jnp.float32))
    c = jnp.cumsum(log_f, axis=1).transpose(0, 2, 1)
    k_pos = jnp.arange(L)
    o_meta = _fox_attend(q[:, :, :N_META], c[:, :, :N_META], k_pos[:N_META],
                         k[:, :, :N_META], v[:, :, :N_META], c[:, :, :N_META], k_pos[:N_META])
    n_blk = (L - N_META) // Q_BLOCK
    q_r = q[:, :, N_META:].reshape(B, N_HEADS, n_blk, Q_BLOCK, HEAD_DIM).transpose(2, 0, 1, 3, 4)
    c_r = c[:, :, N_META:].reshape(B, N_HEADS, n_blk, Q_BLOCK).transpose(2, 0, 1, 3)

    def block(args):
        q_blk, c_blk, idx = args
        q_pos = N_META + idx * Q_BLOCK + jnp.arange(Q_BLOCK)
        return _fox_attend(q_blk, c_blk, q_pos, k, v, c, k_pos)

    o_r = lax.map(block, (q_r, c_r, jnp.arange(n_blk)))
    o_r = o_r.transpose(1, 2, 0, 3, 4).reshape(B, N_HEADS, n_blk * Q_BLOCK, HEAD_DIM)
    o = jnp.concatenate([o_meta, o_r], axis=2).transpose(0, 2, 1, 3).reshape(B, L, ATTN_WIDTH)
    return (o * jax.nn.silu(z)) @ w_out


def pool_mixer(h, w_in, w_grp, scale, w_out):
    B, L, _ = h.shape
    proj = h @ w_in
    u, z = jnp.split(proj, [POOL_WIDTH], axis=-1)
    uf = u.astype(jnp.float32).reshape(B, L, N_POOL_GROUPS, POOL_GROUP)
    t1 = jnp.arange(1, L + 1, dtype=jnp.float32)
    outs = []
    for g, w in enumerate(POOL_WINDOWS):
        ug = uf[:, :, g]
        cs = jnp.pad(jnp.cumsum(ug, axis=1), ((0, 0), (w, 0), (0, 0)))
        win_sum = cs[:, w:] - cs[:, :L]
        cnt = jnp.minimum(t1, float(w))[None, :, None]
        outs.append(win_sum / cnt - ug)
    d = jnp.stack(outs, axis=2)
    d = jnp.einsum('blgc,gce->blge', d, w_grp.astype(jnp.float32)).reshape(B, L, POOL_WIDTH)
    d = (d * scale.astype(jnp.float32)).astype(z.dtype)
    return (d * jax.nn.silu(z)) @ w_out


def setup_inputs(seed: int = 0) -> dict:
    key = jax.random.key(seed)
    ks = jax.random.split(key, 14)
    n = jax.random.normal
    f32 = jnp.float32
    return {
        "x": n(ks[0], (BATCH, SEQ, D_MODEL), f32),
        "meta_tokens": n(ks[1], (N_META, D_MODEL), f32),
        "fox_w_in": n(ks[2], (D_MODEL, FOX_IN_COLS), f32) * D_MODEL ** -0.5,
        "fox_b_f": 2.0 + 0.5 * n(ks[3], (N_HEADS,), f32),
        "fox_w_out": n(ks[4], (ATTN_WIDTH, D_MODEL), f32) * ATTN_WIDTH ** -0.5 * BETA,
        "ln0_g": 1.0 + 0.02 * n(ks[5], (D_MODEL,), f32),
        "ln0_b": 0.02 * n(ks[6], (D_MODEL,), f32),
        "pool_w_in": n(ks[7], (D_MODEL, POOL_IN_COLS), f32) * D_MODEL ** -0.5,
        "pool_w_grp": n(ks[8], (N_POOL_GROUPS, POOL_GROUP, POOL_GROUP), f32) * POOL_GROUP ** -0.5,
        "pool_scale": 1.0 + 0.1 * n(ks[9], (POOL_WIDTH,), f32),
        "pool_w_out": n(ks[10], (POOL_WIDTH, D_MODEL), f32) * POOL_WIDTH ** -0.5 * BETA,
        "ln1_g": 1.0 + 0.02 * n(ks[11], (D_MODEL,), f32),
        "ln1_b": 0.02 * n(ks[12], (D_MODEL,), f32),
    }


def reference(x, meta_tokens, fox_w_in, fox_b_f, fox_w_out, ln0_g, ln0_b,
              pool_w_in, pool_w_grp, pool_scale, pool_w_out, ln1_g, ln1_b):
    B = x.shape[0]
    meta = jnp.broadcast_to(meta_tokens[None].astype(x.dtype), (B, N_META, D_MODEL))
    h = jnp.concatenate([meta, x], axis=1)
    norms = ((ln0_g, ln0_b), (ln1_g, ln1_b))
    for i in range(DEPTH):
        if i % N_MIXERS == 0:
            y = fox_mixer(h, fox_w_in, fox_b_f, fox_w_out)
        else:
            y = pool_mixer(h, pool_w_in, pool_w_grp, pool_scale, pool_w_out)
        g, b = norms[i]
        h = layer_norm(ALPHA * h + y, g, b)
    return h[:, N_META:]
```

```cpp
#include <hip/hip_runtime.h>
#include <hip/hip_cooperative_groups.h>
#include <cstdio>
#include <cstdint>
namespace cg = cooperative_groups;

#ifndef MK_N_LAUNCHES
#define MK_N_LAUNCHES 1
#endif

#define LAS __attribute__((address_space(3)))
typedef unsigned short bf16_t;
typedef short bf16x8 __attribute__((ext_vector_type(8)));
typedef short s16x4 __attribute__((ext_vector_type(4)));
typedef float f32x4 __attribute__((ext_vector_type(4)));
typedef float f32x2 __attribute__((ext_vector_type(2)));
typedef float f32x16 __attribute__((ext_vector_type(16)));
typedef unsigned u32x4 __attribute__((ext_vector_type(4)));
typedef unsigned u32x2 __attribute__((ext_vector_type(2)));

constexpr int DM = 2048, NB = 4, SEQ = 4096, NMETA = 16, NH = 16, HD = 128;
constexpr int M = NB * SEQ;
constexpr int LTOT = SEQ + NMETA;
constexpr int SKV = SEQ + 64;
constexpr int N1 = 8192, N1F = 8208;
constexpr float ALPHA = 1.4142135623730951f;
constexpr float LN_EPS = 1e-5f;
constexpr float ATT_SCALE = 0.08838834764831845f;

constexpr size_t MiB = 1u << 20;
constexpr size_t WS_LOGF = 1 * MiB;
constexpr size_t WS_MB = 3 * MiB;
constexpr size_t WS_PM = 3 * MiB + 256 * 1024;
constexpr size_t WS_GM = 4 * MiB;
constexpr size_t WS_T0M = 4 * MiB + 64 * 1024;
constexpr size_t WS_H1MB = 4 * MiB + 192 * 1024;
constexpr size_t WS_UM = 4 * MiB + 256 * 1024;
constexpr size_t WS_STATS = 5 * MiB;
constexpr size_t WS_W1T = 8 * MiB;
constexpr size_t WS_WOT = 41 * MiB;
constexpr size_t WS_WPT = 49 * MiB;
constexpr size_t WS_WGT = 65 * MiB;
constexpr size_t WS_WO2T = 67 * MiB;
constexpr size_t WS_H0B = 76 * MiB;
constexpr size_t WS_Q = 140 * MiB;
constexpr size_t WS_K = 204 * MiB;
constexpr size_t WS_V = 269 * MiB;
constexpr size_t WS_Z = 334 * MiB;
constexpr size_t WS_END = 398 * MiB;

constexpr int LDS_BYTES = 135168;

__device__ __forceinline__ unsigned cvt_pk_bf16(float lo, float hi) { unsigned r; asm volatile("v_cvt_pk_bf16_f32 %0, %1, %2" : "=v"(r) : "v"(lo), "v"(hi)); return r; }
__device__ __forceinline__ float bf2f(unsigned short v) { return __uint_as_float((unsigned)v << 16); }
__device__ __forceinline__ float bflo(unsigned w) { return __uint_as_float(w << 16); }
__device__ __forceinline__ float bfhi(unsigned w) { return __uint_as_float(w & 0xffff0000u); }
__device__ __forceinline__ float silu_f(float z) { return z * __builtin_amdgcn_rcpf(1.0f + __expf(-z)); }
__device__ __forceinline__ float logsig_f(float x) { return fminf(x, 0.f) - log1pf(expf(-fabsf(x))); }
__device__ __forceinline__ float wave_sum(float v) {
#pragma unroll
    for (int o = 1; o < 64; o <<= 1) v += __shfl_xor(v, o);
    return v;
}
#define LDS_WAIT() asm volatile("s_waitcnt lgkmcnt(0)" ::: "memory")

namespace pg8 {
constexpr int BM = 256, BK = 64, HALF = 128, HTB = HALF * BK * 2, STAGE_BYTES = 8 * HTB, NXCD = 8, WGM = 8;
__host__ __device__ __forceinline__ int lds_byte(int r, int c) { const int st = (r >> 4) * 2 + (c >> 5), rr = r & 15, cc = c & 31, ob = rr * 64 + cc * 2; return st * 1024 + (ob ^ (((ob >> 9) & 1) << 5)); }
__host__ __device__ __forceinline__ void stage_rc(int b, int& R, int& C) { const int st = b / 1024, sb = b % 1024, swz = sb ^ (((sb >> 9) & 1) << 5); R = (st >> 1) * 16 + swz / 64; C = (st & 1) * 32 + (swz % 64) / 2; }
__host__ __device__ __forceinline__ int perm32(int rho) { const int n = rho >> 4, i = rho & 15; return 8 * (i >> 2) + 4 * n + (i & 3); }

struct Unit { int pm, pn; };
struct Gemm { const bf16_t* A; const bf16_t* Bt; int lda, ldb, K, grp; };

struct StaticOrder {
    int nM, nN, nwg, G, c;
    __host__ __device__ void init(int M_, int N_, int G_, int c_) { nM = M_ / BM; nN = N_ / BM; nwg = nM * nN; G = G_; c = c_; }
    __host__ __device__ bool next(int i, Unit& u) const {
        const long L = (long)i * G + c; if (L >= nwg) return false;
        int wgid = (int)L; { const int q = nwg / NXCD, r = nwg % NXCD, xcd = wgid % NXCD, off = wgid / NXCD; wgid = (xcd < r ? xcd * (q + 1) : r * (q + 1) + (xcd - r) * q) + off; }
        const int nig = WGM * nN, gid = wgid / nig, fm = gid * WGM, gsz = (nM - fm) < WGM ? (nM - fm) : WGM;
        u.pm = fm + ((wgid % nig) % gsz); u.pn = (wgid % nig) / gsz; return true;
    }
};

template <class Epi, class Sched, bool ALIGN_EPI>
__device__ __forceinline__ void gemm_phase(LAS unsigned char* lds, const Gemm g, const Sched& S, const Epi& E) {
    const int tid = threadIdx.x, wid = __builtin_amdgcn_readfirstlane(tid >> 6), lane = tid & 63, wr = wid >> 2, wc = wid & 3, fr = lane & 15, fq = lane >> 4;
    const int K = g.K, nt = K / BK;
    unsigned voffA[2], voffB[2];
#pragma unroll
    for (int i = 0; i < 2; ++i) { int R, C; stage_rc(tid * 16 + i * 8192, R, C); const int Rb = Epi::PERM ? ((R & ~31) + perm32(R & 31)) : R;
        voffA[i] = (unsigned)(R * g.lda + C) * 2u; voffB[i] = (unsigned)(Rb * g.ldb + C) * 2u; }
    const size_t kstep = (size_t)(BK * 2);
    const size_t hA = (size_t)HALF * g.lda * 2, hB = (size_t)HALF * g.ldb * 2;
    const unsigned ldsw = (unsigned)wid * 1024u;
    const int aoff = lds_byte(wr * 64 + fr, fq * 8), boff = lds_byte(wc * 32 + fr, fq * 8);
#define PG8_SA(b, h) (((b) * 2 + (h)) * HTB)
#define PG8_SB(b, h) ((4 + (b) * 2 + (h)) * HTB)
#define PG8_STAGE(bufoff, gbase, voff) do { _Pragma("unroll") for (int _i = 0; _i < 2; ++_i) \
        __builtin_amdgcn_global_load_lds((const unsigned*)((const char*)(gbase) + (voff)[_i]), (LAS unsigned*)(lds + (bufoff) + ldsw + _i * 8192), 16, 0, 0); } while (0)
#define PG8_LDA(dst, b, h) do { _Pragma("unroll") for (int m = 0; m < 4; ++m) _Pragma("unroll") for (int k = 0; k < 2; ++k) dst[m][k] = *(const LAS bf16x8*)(lds + PG8_SA(b, h) + aoff + m * 2048 + k * 1024); } while (0)
#define PG8_LDB(dst, b, h) do { _Pragma("unroll") for (int n = 0; n < 2; ++n) _Pragma("unroll") for (int k = 0; k < 2; ++k) dst[n][k] = *(const LAS bf16x8*)(lds + PG8_SB(b, h) + boff + n * 2048 + k * 1024); } while (0)
#define PG8_MMA(ai, bj, At, Bt) do { __builtin_amdgcn_s_setprio(1); _Pragma("unroll") for (int m = 0; m < 4; ++m) _Pragma("unroll") for (int n = 0; n < 2; ++n) _Pragma("unroll") for (int k = 0; k < 2; ++k) \
        acc[ai][bj][m][n] = __builtin_amdgcn_mfma_f32_16x16x32_bf16(Bt[n][k], At[m][k], acc[ai][bj][m][n], 0, 0, 0); __builtin_amdgcn_s_setprio(0); } while (0)
#define PG8_WAIT_V(n) asm volatile("s_waitcnt vmcnt(" #n ")" ::: "memory")
#define PG8_WAIT_L(n) asm volatile("s_waitcnt lgkmcnt(" #n ")" ::: "memory")
#define PG8_BAR __builtin_amdgcn_s_barrier()
#define PG8_SCHED __builtin_amdgcn_sched_barrier(0)
#define PG8_UA(u) ((const char*)g.A + (size_t)(u).pm * 2 * hA + (g.grp ? (size_t)((u).pn / g.grp) * (size_t)K * 2 : (size_t)0))
#define PG8_UB(u) ((const char*)g.Bt + (size_t)(u).pn * 2 * hB)
    Unit cur, nxt; int ui = 0;
    if (!S.next(0, cur)) return;
    f32x4 acc[2][2][4][2];
#pragma unroll
    for (int a = 0; a < 2; ++a)
#pragma unroll
        for (int b = 0; b < 2; ++b)
#pragma unroll
            for (int m = 0; m < 4; ++m)
#pragma unroll
                for (int n = 0; n < 2; ++n) acc[a][b][m][n] = (f32x4){0.f, 0.f, 0.f, 0.f};
    bf16x8 At[4][2], B0[2][2], B1[2][2];
    const char* cA = PG8_UA(cur); const char* cB = PG8_UB(cur);
    PG8_STAGE(PG8_SB(0, 0), cB, voffB); PG8_STAGE(PG8_SB(0, 1), cB + hB, voffB); PG8_STAGE(PG8_SA(0, 0), cA, voffA); PG8_STAGE(PG8_SA(0, 1), cA + hA, voffA);
    if (wr == 1) PG8_BAR;
    PG8_WAIT_V(2); PG8_BAR;
    PG8_STAGE(PG8_SB(1, 0), cB + kstep, voffB); PG8_STAGE(PG8_SA(1, 0), cA + kstep, voffA); PG8_STAGE(PG8_SB(1, 1), cB + hB + kstep, voffB);
    PG8_WAIT_V(6); PG8_BAR;
    for (;;) {
        const bool has_next = S.next(ui + 1, nxt);
        const char* nA = has_next ? PG8_UA(nxt) : cA; const char* nB = has_next ? PG8_UB(nxt) : cB;
        for (int t = 0; t < nt; t += 2) {
            const bool last = (t == nt - 2);
            const char* a1 = cA + (size_t)(t + 1) * kstep;
            const char* a2 = last ? nA : cA + (size_t)(t + 2) * kstep; const char* b2 = last ? nB : cB + (size_t)(t + 2) * kstep;
            const char* a3 = a2 + kstep; const char* b3 = b2 + kstep;
            PG8_LDB(B0, 0, 0); PG8_LDB(B1, 0, 1); PG8_SCHED; PG8_LDA(At, 0, 0); PG8_STAGE(PG8_SA(1, 1), a1 + hA, voffA);
            PG8_WAIT_V(8); PG8_WAIT_L(0); PG8_BAR; PG8_MMA(0, 0, At, B0); PG8_MMA(0, 1, At, B1); PG8_BAR; PG8_SCHED;
            PG8_LDA(At, 0, 1); PG8_STAGE(PG8_SB(0, 0), b2, voffB); PG8_STAGE(PG8_SB(0, 1), b2 + hB, voffB); PG8_STAGE(PG8_SA(0, 0), a2, voffA);
            PG8_WAIT_V(8); PG8_WAIT_L(0); PG8_BAR; PG8_MMA(1, 0, At, B0); PG8_MMA(1, 1, At, B1); PG8_BAR; PG8_SCHED;
            PG8_LDB(B0, 1, 0); PG8_LDB(B1, 1, 1); PG8_SCHED; PG8_LDA(At, 1, 0); PG8_STAGE(PG8_SA(0, 1), a2 + hA, voffA);
            PG8_WAIT_V(8); PG8_WAIT_L(0); PG8_BAR; PG8_MMA(0, 0, At, B0); PG8_MMA(0, 1, At, B1); PG8_BAR; PG8_SCHED;
            PG8_LDA(At, 1, 1); PG8_STAGE(PG8_SB(1, 0), b3, voffB); PG8_STAGE(PG8_SB(1, 1), b3 + hB, voffB); PG8_STAGE(PG8_SA(1, 0), a3, voffA);
            PG8_WAIT_V(8); PG8_WAIT_L(0); PG8_BAR; PG8_MMA(1, 0, At, B0); PG8_MMA(1, 1, At, B1); PG8_BAR; PG8_SCHED;
        }
        if constexpr (ALIGN_EPI) { if (wr == 0) PG8_BAR; }
        E(acc, cur, wr, wc, fr, fq);
        if (!has_next) break;
#pragma unroll
        for (int a = 0; a < 2; ++a)
#pragma unroll
            for (int b = 0; b < 2; ++b)
#pragma unroll
                for (int m = 0; m < 4; ++m)
#pragma unroll
                    for (int n = 0; n < 2; ++n) acc[a][b][m][n] = (f32x4){0.f, 0.f, 0.f, 0.f};
        cur = nxt; cA = nA; cB = nB; ++ui;
        if constexpr (ALIGN_EPI) { if (wr == 1) PG8_BAR; }
    }
    PG8_WAIT_V(0);
    if constexpr (!ALIGN_EPI) { if (wr == 0) PG8_BAR; }
    PG8_BAR;
#undef PG8_SA
#undef PG8_SB
#undef PG8_STAGE
#undef PG8_LDA
#undef PG8_LDB
#undef PG8_MMA
#undef PG8_WAIT_V
#undef PG8_WAIT_L
#undef PG8_BAR
#undef PG8_SCHED
#undef PG8_UA
#undef PG8_UB
}

__device__ __forceinline__ u32x4 pack8f(f32x4 a, f32x4 b) { u32x4 w; w.x = cvt_pk_bf16(a[0], a[1]); w.y = cvt_pk_bf16(a[2], a[3]); w.z = cvt_pk_bf16(b[0], b[1]); w.w = cvt_pk_bf16(b[2], b[3]); return w; }

struct EpiQKVZ {
    static constexpr bool PERM = true;
    bf16_t *Q, *Kb, *Vb, *Z;
    __device__ __forceinline__ void operator()(const f32x4 (&acc)[2][2][4][2], const Unit& u, int wr, int wc, int fr, int fq) const {
        const int t = u.pn >> 3, hbase = (u.pn & 7) * 2, d = wc * 32 + 8 * fq;
#pragma unroll
        for (int ai = 0; ai < 2; ++ai)
#pragma unroll
            for (int m = 0; m < 4; ++m) {
                const int row = u.pm * BM + ai * HALF + wr * 64 + m * 16 + fr, b = row >> 12, i = row & 4095;
#pragma unroll
                for (int bj = 0; bj < 2; ++bj) {
                    const int h = hbase + bj; bf16_t* p;
                    if (t == 0) p = Q + ((size_t)((b * NH + h) * SEQ + i)) * HD + d;
                    else if (t == 3) p = Z + (size_t)row * DM + h * HD + d;
                    else p = (t == 1 ? Kb : Vb) + ((size_t)((b * NH + h) * SKV + 64 + i)) * HD + d;
                    *(u32x4*)p = pack8f(acc[ai][bj][m][0], acc[ai][bj][m][1]);
                }
            }
    }
};
struct EpiSplit2 {
    static constexpr bool PERM = true;
    bf16_t *O0, *O1;
    __device__ __forceinline__ void operator()(const f32x4 (&acc)[2][2][4][2], const Unit& u, int wr, int wc, int fr, int fq) const {
        bf16_t* base = (u.pn < 8 ? O0 : O1) + (u.pn & 7) * BM + wc * 32 + 8 * fq;
#pragma unroll
        for (int ai = 0; ai < 2; ++ai)
#pragma unroll
            for (int m = 0; m < 4; ++m) {
                const int row = u.pm * BM + ai * HALF + wr * 64 + m * 16 + fr;
#pragma unroll
                for (int bj = 0; bj < 2; ++bj) *(u32x4*)(base + (size_t)row * DM + bj * HALF) = pack8f(acc[ai][bj][m][0], acc[ai][bj][m][1]);
            }
    }
};
struct EpiT0 {
    static constexpr bool PERM = false;
    const float* X; float* O;
    __device__ __forceinline__ void operator()(const f32x4 (&acc)[2][2][4][2], const Unit& u, int wr, int wc, int fr, int fq) const {
        const int col0 = u.pn * BM + wc * 32 + 4 * fq;
#pragma unroll
        for (int ai = 0; ai < 2; ++ai)
#pragma unroll
            for (int m = 0; m < 4; ++m) {
                const size_t off = (size_t)(u.pm * BM + ai * HALF + wr * 64 + m * 16 + fr) * DM + col0;
#pragma unroll
                for (int bj = 0; bj < 2; ++bj)
#pragma unroll
                    for (int n = 0; n < 2; ++n) { const f32x4 xv = *(const f32x4*)(X + off + bj * HALF + n * 16); *(f32x4*)(O + off + bj * HALF + n * 16) = xv * ALPHA + acc[ai][bj][m][n]; }
            }
    }
};
struct EpiGate {
    static constexpr bool PERM = true;
    const bf16_t* Z1; const float* scale; bf16_t* O;
    __device__ __forceinline__ void operator()(const f32x4 (&acc)[2][2][4][2], const Unit& u, int wr, int wc, int fr, int fq) const {
        const int col0 = u.pn * BM + wc * 32 + 8 * fq;
        f32x4 sv[2][2];
#pragma unroll
        for (int bj = 0; bj < 2; ++bj) { sv[bj][0] = *(const f32x4*)(scale + col0 + bj * HALF); sv[bj][1] = *(const f32x4*)(scale + col0 + bj * HALF + 4); }
#pragma unroll
        for (int ai = 0; ai < 2; ++ai)
#pragma unroll
            for (int m = 0; m < 4; ++m) {
                const size_t off = (size_t)(u.pm * BM + ai * HALF + wr * 64 + m * 16 + fr) * DM + col0;
#pragma unroll
                for (int bj = 0; bj < 2; ++bj) {
                    const u32x4 zw = *(const u32x4*)(Z1 + off + bj * HALF);
                    f32x4 v0 = acc[ai][bj][m][0] * sv[bj][0], v1 = acc[ai][bj][m][1] * sv[bj][1];
                    v0[0] *= silu_f(bflo(zw.x)); v0[1] *= silu_f(bfhi(zw.x)); v0[2] *= silu_f(bflo(zw.y)); v0[3] *= silu_f(bfhi(zw.y));
                    v1[0] *= silu_f(bflo(zw.z)); v1[1] *= silu_f(bfhi(zw.z)); v1[2] *= silu_f(bflo(zw.w)); v1[3] *= silu_f(bfhi(zw.w));
                    *(u32x4*)(O + off + bj * HALF) = pack8f(v0, v1);
                }
            }
    }
};
struct EpiT1 {
    static constexpr bool PERM = false;
    float* T; const float* stats; const float* g; const float* bb;
    __device__ __forceinline__ void operator()(const f32x4 (&acc)[2][2][4][2], const Unit& u, int wr, int wc, int fr, int fq) const {
        const int col0 = u.pn * BM + wc * 32 + 4 * fq;
        f32x4 gv[2][2], bv[2][2];
#pragma unroll
        for (int bj = 0; bj < 2; ++bj)
#pragma unroll
            for (int n = 0; n < 2; ++n) { gv[bj][n] = *(const f32x4*)(g + col0 + bj * HALF + n * 16); bv[bj][n] = *(const f32x4*)(bb + col0 + bj * HALF + n * 16); }
#pragma unroll
        for (int ai = 0; ai < 2; ++ai)
#pragma unroll
            for (int m = 0; m < 4; ++m) {
                const int row = u.pm * BM + ai * HALF + wr * 64 + m * 16 + fr;
                const f32x2 st = *(const f32x2*)(stats + 2 * (size_t)row);
                const size_t off = (size_t)row * DM + col0;
#pragma unroll
                for (int bj = 0; bj < 2; ++bj)
#pragma unroll
                    for (int n = 0; n < 2; ++n) { const f32x4 tv = *(const f32x4*)(T + off + bj * HALF + n * 16);
                        const f32x4 h1 = (tv - st.x) * st.y * gv[bj][n] + bv[bj][n];
                        *(f32x4*)(T + off + bj * HALF + n * 16) = h1 * ALPHA + acc[ai][bj][m][n]; }
            }
    }
};
}

namespace att {
constexpr int D = 128, NW = 8, QBLK = 32, KVBLK = 64, QB = 256;
constexpr int SHM_V = KVBLK * D * 2, SHM_K = KVBLK * D * 2;
constexpr int OFF_WS = 2 * SHM_V + 2 * SHM_K;
constexpr int OFF_NBK = OFF_WS + NW * 64 * 4;
constexpr int OFF_SCAN = OFF_NBK + SKV * 4;
constexpr int ATT_LDS = OFF_SCAN + 64;
constexpr float SCALE = ATT_SCALE;
constexpr float THR = 8.f;
#define KSWZ(row, colB) ((row) * 256 + ((colB) ^ (((row) & 7) << 4)))
#define SBAR() __builtin_amdgcn_sched_barrier(0)
__device__ __forceinline__ int v_st(int k, int c) { const int kk = (k & ~0xC) | ((k & 4) << 1) | ((k & 8) >> 1); return ((kk >> 3) * 4 + (c >> 5)) * 512 + ((kk & 7) * 32 + (c & 31)) * 2; }
__device__ __forceinline__ int v_rd_base(int lane) { return ((lane & 3) << 3) | (((lane >> 2) & 3) << 6) | (((lane >> 4) & 1) << 5) | (((lane >> 5) & 1) << 8); }
constexpr int v_rd_off(int d0, int ks, int half) { return d0 * 512 + ks * 4096 + half * 2048; }
__device__ __forceinline__ int crow(int r, int hi) { return (r & 3) + 8 * (r >> 2) + 4 * hi; }
__device__ __forceinline__ bf16x8 load8(const bf16_t* p) { return *reinterpret_cast<const bf16x8*>(p); }
__device__ __forceinline__ void mask_tile(f32x16& p0, f32x16& p1, int dq) {
    const float NEG = -__builtin_inff();
#pragma unroll
    for (int r = 0; r < 16; ++r) {
        const int c = (r & 3) + 8 * (r >> 2);
        if (dq - c < 0) p0[r] = NEG;
        if (dq - c - 32 < 0) p1[r] = NEG;
    }
}
__device__ __forceinline__ void partialSM(f32x16& p0, f32x16& p1, float& m_reg, float& mn, float& alpha) {
    float pmax = p0[0];
#pragma unroll
    for (int r = 1; r < 16; ++r) pmax = fmaxf(pmax, p0[r]);
#pragma unroll
    for (int r = 0; r < 16; ++r) pmax = fmaxf(pmax, p1[r]);
    { auto rr = __builtin_amdgcn_permlane32_swap(__float_as_uint(pmax), __float_as_uint(pmax), false, false);
      pmax = fmaxf(__uint_as_float(rr[0]), __uint_as_float(rr[1])); }
    constexpr float C2 = 1.4426950408889634f * SCALE;
    if (__builtin_expect(__all((pmax - m_reg) * SCALE <= THR), 1)) { mn = m_reg; alpha = 1.f; }
    else { mn = fmaxf(m_reg, pmax); alpha = __builtin_amdgcn_exp2f((m_reg - mn) * C2); m_reg = mn; }
    const float mnL = -mn * C2;
#pragma unroll
    for (int r = 0; r < 16; ++r) p0[r] = fmaf(p0[r], C2, mnL);
#pragma unroll
    for (int r = 0; r < 16; ++r) p1[r] = fmaf(p1[r], C2, mnL);
#pragma unroll
    for (int r = 0; r < 16; ++r) p0[r] = __builtin_amdgcn_exp2f(p0[r]);
}
__device__ __forceinline__ void finishSM(f32x16& p0, f32x16& p1, float alpha, float& l_reg, bf16x8& pa0, bf16x8& pa1, bf16x8& pa2, bf16x8& pa3) {
#pragma unroll
    for (int r = 0; r < 16; ++r) p1[r] = __builtin_amdgcn_exp2f(p1[r]);
    float ps = 0;
#pragma unroll
    for (int r = 0; r < 16; ++r) ps += p0[r];
#pragma unroll
    for (int r = 0; r < 16; ++r) ps += p1[r];
    { auto rr = __builtin_amdgcn_permlane32_swap(__float_as_uint(ps), __float_as_uint(ps), false, false);
      ps = __uint_as_float(rr[0]) + __uint_as_float(rr[1]); }
    l_reg = l_reg * alpha + ps;
#define PK4(P, B_, OUT) do { unsigned a0 = cvt_pk_bf16(P[B_+0], P[B_+1]), a1 = cvt_pk_bf16(P[B_+2], P[B_+3]);                          \
        unsigned b0 = cvt_pk_bf16(P[B_+4], P[B_+5]), b1 = cvt_pk_bf16(P[B_+6], P[B_+7]);                                             \
        auto r0 = __builtin_amdgcn_permlane32_swap(a0, b0, false, false); auto r1 = __builtin_amdgcn_permlane32_swap(a1, b1, false, false); \
        u32x4 w = {r0[0], r1[0], r0[1], r1[1]}; OUT = *reinterpret_cast<bf16x8*>(&w); } while (0)
    PK4(p0, 0, pa0); PK4(p0, 8, pa1); PK4(p1, 0, pa2); PK4(p1, 8, pa3);
#undef PK4
}
template <int KB>
__device__ __forceinline__ void qkt(f32x16& p0, f32x16& p1, const char* K_lds, const float* nbk_t, int r32, int hi, const bf16x8* qr) {
    const f32x4* bp = (const f32x4*)(nbk_t + 4 * hi);
#pragma unroll
    for (int g = 0; g < 4; ++g) { const f32x4 a = bp[2 * g], b = bp[8 + 2 * g];
        p0[4 * g] = a[0]; p0[4 * g + 1] = a[1]; p0[4 * g + 2] = a[2]; p0[4 * g + 3] = a[3];
        p1[4 * g] = b[0]; p1[4 * g + 1] = b[1]; p1[4 * g + 2] = b[2]; p1[4 * g + 3] = b[3]; }
    const char* kb[4];
#pragma unroll
    for (int dd = 0; dd < 4; ++dd) kb[dd] = K_lds + KB * SHM_K + KSWZ(r32, (dd * 16 + hi * 8) * 2);
#pragma unroll
    for (int d0 = 0; d0 < 8; ++d0) { const char* a = kb[d0 & 3] + (d0 >> 2) * 128;
        bf16x8 b0 = *reinterpret_cast<const bf16x8*>(a);
        bf16x8 b1 = *reinterpret_cast<const bf16x8*>(a + 32 * 256);
        p0 = __builtin_amdgcn_mfma_f32_32x32x16_bf16(b0, qr[d0], p0, 0, 0, 0);
        p1 = __builtin_amdgcn_mfma_f32_32x32x16_bf16(b1, qr[d0], p1, 0, 0, 0); }
}
template <int VB>
__device__ __forceinline__ void pv_tile(f32x16* o, int vb0, bf16x8 pa0, bf16x8 pa1, bf16x8 pa2, bf16x8 pa3) {
#define TRRD(dst, off) asm volatile("ds_read_b64_tr_b16 %0, %1 offset:%2" : "=&v"(dst) : "v"(vb0), "i"(off) : "memory")
#define PV_D0(d0) do { s16x4 l0, l1, l2, l3, h0, h1, h2, h3; constexpr int b_ = VB * SHM_V + v_rd_off(d0, 0, 0); \
        TRRD(l0, b_); TRRD(h0, b_ + 2048); TRRD(l1, b_ + 4096); TRRD(h1, b_ + 6144); TRRD(l2, b_ + 8192); TRRD(h2, b_ + 10240); TRRD(l3, b_ + 12288); TRRD(h3, b_ + 14336); \
        asm volatile("s_waitcnt lgkmcnt(0)" ::: "memory"); SBAR();   \
        o[d0] = __builtin_amdgcn_mfma_f32_32x32x16_bf16(pa0, (bf16x8){l0[0], l0[1], l0[2], l0[3], h0[0], h0[1], h0[2], h0[3]}, o[d0], 0, 0, 0);   \
        o[d0] = __builtin_amdgcn_mfma_f32_32x32x16_bf16(pa1, (bf16x8){l1[0], l1[1], l1[2], l1[3], h1[0], h1[1], h1[2], h1[3]}, o[d0], 0, 0, 0);   \
        o[d0] = __builtin_amdgcn_mfma_f32_32x32x16_bf16(pa2, (bf16x8){l2[0], l2[1], l2[2], l2[3], h2[0], h2[1], h2[2], h2[3]}, o[d0], 0, 0, 0);   \
        o[d0] = __builtin_amdgcn_mfma_f32_32x32x16_bf16(pa3, (bf16x8){l3[0], l3[1], l3[2], l3[3], h3[0], h3[1], h3[2], h3[3]}, o[d0], 0, 0, 0); } while (0)
    PV_D0(0); PV_D0(1); PV_D0(2); PV_D0(3);
#undef PV_D0
#undef TRRD
}

struct BlockRef { const bf16_t* Q; const bf16_t* K; int P0; int row0; int h; };
struct Seam { bf16x8 qr[8]; bf16x8 st_v0, st_v1, st_k0, st_k1; };
constexpr size_t VDELTA = (WS_V - WS_K) / 2;
__device__ __forceinline__ bf16x8 load8o(const bf16_t* base, unsigned byteoff) { return *reinterpret_cast<const bf16x8*>((const char*)base + byteoff); }
#define ROWB(k0, rr) (rowoff + (unsigned)(((k0) + (rr)) * D * 2))
#define VMW() asm volatile("s_waitcnt vmcnt(0)" ::: "memory")
#define VMWN(n) asm volatile("s_waitcnt vmcnt(%0)" :: "i"(n) : "memory")
#define SLOAD_H(Kp, k0) do { S.st_v0 = load8o((Kp) + VDELTA, ROWB(k0, 0)); S.st_v1 = load8o((Kp) + VDELTA, ROWB(k0, 32));              \
                         S.st_k0 = load8o(Kp, ROWB(k0, 0)); S.st_k1 = load8o(Kp, ROWB(k0, 32)); } while (0)
#define SWRITE_HK(bf) do { *(bf16x8*)(K_lds + (bf) * SHM_K + kws) = S.st_k0; *(bf16x8*)(K_lds + (bf) * SHM_K + kws + 32 * 256) = S.st_k1; } while (0)
#define SWRITE_HV(bf) do { *(bf16x8*)(V_lds + (bf) * SHM_V + vst0) = S.st_v0; *(bf16x8*)(V_lds + (bf) * SHM_V + vst1) = S.st_v1; } while (0)
#define SWRITE_H(bf) do { SWRITE_HV(bf); SWRITE_HK(bf); } while (0)
__device__ __forceinline__ void prime(const BlockRef& cur, char* lds, Seam& S) {
    const int tid = threadIdx.x, wid = __builtin_amdgcn_readfirstlane(tid >> 6), lane = tid & 63, r32 = lane & 31, hi = lane >> 5;
    const int sr = tid >> 4, sc = (tid & 15) * 8, kws = KSWZ(sr, sc * 2); char* K_lds = lds + 2 * SHM_V;
    const unsigned rowoff = (unsigned)(sr * D + sc) * 2u, qoff = (unsigned)((wid * QBLK + r32) * D + hi * 8) * 2u;
#pragma unroll
    for (int d0 = 0; d0 < 8; ++d0) S.qr[d0] = load8o(cur.Q, qoff + d0 * 32);
    SLOAD_H(cur.K, 0); VMW(); SWRITE_HK(0);
    __syncthreads();
}
__device__ __forceinline__ void block(const BlockRef& cur, const BlockRef& nxt, char* lds, Seam& S, const bf16_t* __restrict__ Zg, bf16_t* __restrict__ G) {
    const int tid = threadIdx.x, wid = __builtin_amdgcn_readfirstlane(tid >> 6), lane = tid & 63, r32 = lane & 31, hi = lane >> 5;
    const int NT = (cur.P0 + QB - 1) / KVBLK + 1;
    const int qlo = cur.P0 + wid * QBLK, qm = qlo + r32 - 4 * hi;
    char* V_lds = lds; char* K_lds = lds + 2 * SHM_V;
    float* ws = (float*)(lds + OFF_WS) + wid * 64; float* li_l = ws; float* al_l = ws + 32;
    const float* nbk = (const float*)(lds + OFF_NBK);
    float m_reg = -1e30f, l_reg = 0; f32x16 o[4] = {};
    const int sr = tid >> 4, sc = (tid & 15) * 8, vst0 = v_st(sr, sc), vst1 = v_st(32 + sr, sc), kws = KSWZ(sr, sc * 2);
    const int vb0 = (int)(uintptr_t)V_lds + v_rd_base(lane);
    const bf16_t* Kh = cur.K;
    const unsigned rowoff = (unsigned)(sr * D + sc) * 2u, qoff = (unsigned)((wid * QBLK + r32) * D + hi * 8) * 2u;
#define RESC(a) do { if (__any((a) < 1.f)) { if (hi == 0) al_l[r32] = (a); asm volatile("s_waitcnt lgkmcnt(0)" ::: "memory");              \
                     _Pragma("unroll") for (int d_ = 0; d_ < 4; ++d_) _Pragma("unroll") for (int r = 0; r < 16; ++r) o[d_][r] *= al_l[crow(r, hi)]; } } while (0)
#define KBASE(t) ((t) * KVBLK)
#define MASKT(P0_, P1_, t) do { const int kb_ = KBASE(t); if (kb_ + KVBLK - 1 > qlo) mask_tile(P0_, P1_, qm - kb_); } while (0)
#define SEAM_K0() do { VMWN(8); SWRITE_HK(0); SBAR(); } while (0)
    f32x16 pA0, pA1, pB0, pB1; float mnA, mnB, alA, alB; bf16x8 pa0, pa1, pa2, pa3;
    SWRITE_HV(0); SBAR();
    if (NT > 1) SLOAD_H(Kh, KBASE(1));
    SBAR(); qkt<0>(pA0, pA1, K_lds, nbk, r32, hi, S.qr);
    MASKT(pA0, pA1, 0); partialSM(pA0, pA1, m_reg, mnA, alA);
    if (NT > 1) { VMW(); SWRITE_H(1); }
    __syncthreads();
#define HALF_STEP(PX0, PX1, mnX, alX, PY0, PY1, alY, t, KB, VB, SB) do {                                                      \
        SBAR(); qkt<KB>(PX0, PX1, K_lds, nbk + (t) * KVBLK, r32, hi, S.qr);                                                   \
        finishSM(PY0, PY1, alY, l_reg, pa0, pa1, pa2, pa3); SBAR();                                                           \
        if ((t) + 1 < NT) { SLOAD_H(Kh, KBASE((t) + 1)); SBAR(); }                                                        \
        pv_tile<VB>(o, vb0, pa0, pa1, pa2, pa3); MASKT(PX0, PX1, (t)); partialSM(PX0, PX1, m_reg, mnX, alX);                  \
        __syncthreads();                                                                                                      \
        if ((t) + 1 < NT) { VMW(); SWRITE_H(SB); }                                                                            \
        RESC(alX); __syncthreads(); } while (0)
    for (int t = 1; t + 1 < NT; t += 2) {
        HALF_STEP(pB0, pB1, mnB, alB, pA0, pA1, alA, t, 1, 0, 0);
        HALF_STEP(pA0, pA1, mnA, alA, pB0, pB1, alB, t + 1, 0, 1, 1);
    }
    SLOAD_H(nxt.K, 0); SBAR();
#pragma unroll
    for (int d0 = 0; d0 < 8; ++d0) S.qr[d0] = load8o(nxt.Q, qoff + d0 * 32);
    SBAR();
    finishSM(pA0, pA1, alA, l_reg, pa0, pa1, pa2, pa3); SBAR();
    pv_tile<0>(o, vb0, pa0, pa1, pa2, pa3);
    SBAR(); SEAM_K0();
    if (hi == 0) li_l[r32] = l_reg; asm volatile("s_waitcnt lgkmcnt(0)" ::: "memory");
    {
        float* stgA = (float*)(lds + (wid < 4 ? SHM_V + wid * 4096 : 2 * SHM_V + SHM_K + (wid - 4) * 4096));
        float* stgB = (float*)(lds + ATT_LDS + wid * 4096);
        const bf16_t* zp = Zg + (size_t)(cur.row0 + wid * QBLK) * DM + cur.h * HD + (size_t)(lane >> 4) * DM + (lane & 15) * 8;
        bf16_t* gp = G + (size_t)(cur.row0 + wid * QBLK) * DM + cur.h * HD + (size_t)(lane >> 4) * DM + (lane & 15) * 8;
        u32x4 zv[2][4];
#pragma unroll
        for (int p = 0; p < 2; ++p)
#pragma unroll
            for (int k = 0; k < 4; ++k) zv[p][k] = *(const u32x4*)(zp + (size_t)(16 * p + 4 * k) * DM);
        float rli[16];
#pragma unroll
        for (int r = 0; r < 16; ++r) rli[r] = __builtin_amdgcn_rcpf(li_l[crow(r, hi)]);
#pragma unroll
        for (int p = 0; p < 2; ++p) {
#pragma unroll
            for (int rr = 0; rr < 8; ++rr) { const int r = 8 * p + rr; float* dst = ((rr >> 2) ? stgB : stgA) + ((rr & 3) + 4 * hi) * 128 + r32;
#pragma unroll
                for (int d0 = 0; d0 < 4; ++d0) dst[d0 * 32] = o[d0][r] * rli[r]; }
            asm volatile("s_waitcnt lgkmcnt(0)" ::: "memory");
#pragma unroll
            for (int k = 0; k < 4; ++k) { const float* src = ((k >> 1) ? stgB : stgA) + (((k & 1) * 4 + (lane >> 4)) * 128 + (lane & 15) * 8);
                const f32x4 a0 = *(const f32x4*)src, a1 = *(const f32x4*)(src + 4); const u32x4 zw = zv[p][k];
                u32x4 w;
                w.x = cvt_pk_bf16(a0[0] * silu_f(bflo(zw.x)), a0[1] * silu_f(bfhi(zw.x))); w.y = cvt_pk_bf16(a0[2] * silu_f(bflo(zw.y)), a0[3] * silu_f(bfhi(zw.y)));
                w.z = cvt_pk_bf16(a1[0] * silu_f(bflo(zw.z)), a1[1] * silu_f(bfhi(zw.z))); w.w = cvt_pk_bf16(a1[2] * silu_f(bflo(zw.w)), a1[3] * silu_f(bfhi(zw.w)));
                *(u32x4*)(gp + (size_t)(16 * p + 4 * k) * DM) = w; }
            asm volatile("s_waitcnt lgkmcnt(0)" ::: "memory");
        }
    }
    __syncthreads();
#undef RESC
#undef KBASE
#undef MASKT
#undef SEAM_K0
#undef HALF_STEP
}
#undef ROWB
#undef VMWN
#undef SLOAD_H
#undef SWRITE_HK
#undef SWRITE_HV
#undef SWRITE_H

__device__ __forceinline__ void load_nbk(const float* __restrict__ lf, char* lds) {
    float* nbk = (float*)(lds + OFF_NBK); float* scr = (float*)(lds + OFF_SCAN);
    const int tid = threadIdx.x, lane = tid & 63, wid = tid >> 6, base = tid * 9;
    float v[9]; float s = 0.f;
#pragma unroll
    for (int j = 0; j < 9; ++j) { const int p = base + j; v[j] = p < LTOT ? lf[p] : 0.f; s += v[j]; }
    float incl = s;
#pragma unroll
    for (int off = 1; off < 64; off <<= 1) { const float t = __shfl_up(incl, off); if (lane >= off) incl += t; }
    if (lane == 63) scr[wid] = incl;
    __syncthreads();
    float wp = 0.f;
#pragma unroll
    for (int w = 0; w < 8; ++w) if (w < wid) wp += scr[w];
    float c = wp + incl - s;
    constexpr float INV = 1.0f / SCALE;
#pragma unroll
    for (int j = 0; j < 9; ++j) { c += v[j]; const int p = base + j; if (p < LTOT) { const int kk = p < NMETA ? p : p + 48; nbk[kk] = -c * INV; } }
    if (tid < 48) nbk[16 + tid] = -1e30f;
    __syncthreads();
}
struct Item { int bh, qb0, qb1; };
__device__ __forceinline__ Item decode(int L) { Item it; const int xcd = L & 7, k = L >> 3; it.bh = (k >> 3) * 8 + xcd; const int x = k & 7; it.qb0 = x; it.qb1 = 15 - x; return it; }
__device__ __forceinline__ BlockRef mkref(const Item& it, int pass, const bf16_t* Q, const bf16_t* K) {
    const int qb = pass ? it.qb1 : it.qb0; BlockRef r;
    r.Q = Q + ((size_t)it.bh * SEQ + (size_t)qb * QB) * D; r.K = K + (size_t)it.bh * SKV * D;
    r.P0 = 64 + qb * QB; r.row0 = (it.bh >> 4) * SEQ + qb * QB; r.h = it.bh & 15; return r;
}
__device__ __forceinline__ void attn_phase(char* lds, const bf16_t* Q, const bf16_t* K, const bf16_t* V, const bf16_t* Zg, bf16_t* G, const float* logf) {
    const int total = 512, stride = gridDim.x;
    int L = blockIdx.x; if (L >= total) return;
    Item it = decode(L); int pass = 0;
    BlockRef cur = mkref(it, 0, Q, K);
    load_nbk(logf + (size_t)it.bh * LTOT, lds);
    Seam S;
    prime(cur, lds, S);
    for (;;) {
        const bool more_pass = pass == 0, more_item = L + stride < total, last = !more_pass && !more_item;
        Item itn = it; int passn = pass + 1, Ln = L;
        if (!more_pass) { passn = 0; Ln = more_item ? L + stride : L; itn = decode(Ln); }
        const BlockRef nxt = last ? cur : mkref(itn, passn, Q, K);
        block(cur, nxt, lds, S, Zg, G);
        if (last) break;
        if (itn.bh != it.bh) load_nbk(logf + (size_t)itn.bh * LTOT, lds);
        cur = nxt; it = itn; pass = passn; L = Ln;
    }
}
#undef VMW
#undef SBAR
#undef KSWZ
}

__device__ __forceinline__ f32x4 wave_gemm16(const bf16_t* __restrict__ A, int lda, const bf16_t* __restrict__ Bt, int ldb, int K, int lane) {
    const int fr = lane & 15, fq = lane >> 4;
    const bf16_t* ap = A + (size_t)fr * lda + fq * 8; const bf16_t* bp = Bt + (size_t)fr * ldb + fq * 8;
    f32x4 acc = {0.f, 0.f, 0.f, 0.f};
#pragma unroll 8
    for (int k0 = 0; k0 < K; k0 += 32) {
        const bf16x8 a = *(const bf16x8*)(ap + k0), b = *(const bf16x8*)(bp + k0);
        acc = __builtin_amdgcn_mfma_f32_16x16x32_bf16(a, b, acc, 0, 0, 0);
    }
    return acc;
}

struct Args {
    const float* x; const float* meta; const float* w_in; const float* b_f; const float* w_out; const float* ln0_g; const float* ln0_b;
    const float* pw_in; const float* pw_grp; const float* p_scale; const float* pw_out; const float* ln1_g; const float* ln1_b;
    float* out; unsigned char* ws; int ph_lo, ph_hi;
};
constexpr int N_PHASES = 10;

__device__ __forceinline__ void p0_transpose_item(const float* __restrict__ W, int K, int ldw, int nblk, bf16_t* __restrict__ WT, LAS float* scr, int item, int lane) {
    const int kb = item / nblk, nb = item % nblk, k0 = 64 * kb, n0 = 32 * nb;
#pragma unroll 8
    for (int i = 0; i < 32; ++i) { const int kk = 2 * i + (lane >> 5); scr[kk * 33 + (lane & 31)] = W[(size_t)(k0 + kk) * ldw + n0 + (lane & 31)]; }
    LDS_WAIT(); asm volatile("" ::: "memory");
    const int c = lane & 7;
#pragma unroll
    for (int j = 0; j < 4; ++j) { const int n = (lane >> 3) + 8 * j; const LAS float* s = scr + (8 * c) * 33 + n;
        u32x4 o; o.x = cvt_pk_bf16(s[0 * 33], s[1 * 33]); o.y = cvt_pk_bf16(s[2 * 33], s[3 * 33]); o.z = cvt_pk_bf16(s[4 * 33], s[5 * 33]); o.w = cvt_pk_bf16(s[6 * 33], s[7 * 33]);
        *(u32x4*)(WT + (size_t)(n0 + n) * K + k0 + 8 * c) = o; }
    LDS_WAIT(); asm volatile("" ::: "memory");
}
__device__ __forceinline__ void row_to_bf16(const float* __restrict__ xrow, bf16_t* __restrict__ orow, int lane) {
    const f32x4* xr = (const f32x4*)xrow + lane; u32x2* o8 = (u32x2*)orow + lane;
    f32x4 v[8];
#pragma unroll
    for (int j = 0; j < 8; ++j) v[j] = xr[64 * j];
#pragma unroll
    for (int j = 0; j < 8; ++j) { u32x2 w; w.x = cvt_pk_bf16(v[j][0], v[j][1]); w.y = cvt_pk_bf16(v[j][2], v[j][3]); o8[64 * j] = w; }
}
__device__ __forceinline__ void ln_row(const float* __restrict__ trow, const float* __restrict__ g, const float* __restrict__ bb, bf16_t* ob, float* of, float* st, int lane) {
    const f32x4* xr = (const f32x4*)trow + lane;
    f32x4 v[8]; float s = 0.f;
#pragma unroll
    for (int j = 0; j < 8; ++j) { v[j] = xr[64 * j]; s += (v[j][0] + v[j][1]) + (v[j][2] + v[j][3]); }
    const float mean = wave_sum(s) * (1.f / DM); float s2 = 0.f;
#pragma unroll
    for (int j = 0; j < 8; ++j) { const f32x4 d = v[j] - mean; s2 += (d[0] * d[0] + d[1] * d[1]) + (d[2] * d[2] + d[3] * d[3]); }
    const float rstd = 1.0f / sqrtf(wave_sum(s2) * (1.f / DM) + LN_EPS);
    if (st && lane == 0) { st[0] = mean; st[1] = rstd; }
#pragma unroll
    for (int j = 0; j < 8; ++j) {
        const f32x4 gv = ((const f32x4*)g)[lane + 64 * j], bv = ((const f32x4*)bb)[lane + 64 * j];
        const f32x4 y = (v[j] - mean) * rstd * gv + bv;
        if (of) ((f32x4*)of)[lane + 64 * j] = y;
        if (ob) { u32x2 w; w.x = cvt_pk_bf16(y[0], y[1]); w.y = cvt_pk_bf16(y[2], y[3]); ((u32x2*)ob)[lane + 64 * j] = w; }
    }
}

__global__ void __launch_bounds__(512, 2) fwd(Args a) {
    extern __shared__ __attribute__((aligned(16))) unsigned char lds[];
    const int tid = threadIdx.x, lane = tid & 63, wid = __builtin_amdgcn_readfirstlane(tid >> 6);
    const int G = gridDim.x, bx = blockIdx.x;
    const int gw = bx * 8 + wid, NGW = G * 8;
    unsigned char* ws = a.ws;
    float* LOGF = (float*)(ws + WS_LOGF); bf16_t* MB = (bf16_t*)(ws + WS_MB); float* PM = (float*)(ws + WS_PM); bf16_t* GM = (bf16_t*)(ws + WS_GM);
    float* T0M = (float*)(ws + WS_T0M); bf16_t* H1MB = (bf16_t*)(ws + WS_H1MB); float* UM = (float*)(ws + WS_UM); float* STATS = (float*)(ws + WS_STATS);
    bf16_t* W1T = (bf16_t*)(ws + WS_W1T); bf16_t* WOT = (bf16_t*)(ws + WS_WOT); bf16_t* WPT = (bf16_t*)(ws + WS_WPT); bf16_t* WGT = (bf16_t*)(ws + WS_WGT); bf16_t* WO2T = (bf16_t*)(ws + WS_WO2T);
    bf16_t* H0B = (bf16_t*)(ws + WS_H0B); bf16_t* GB = H0B; bf16_t* EB = H0B;
    bf16_t* QB_ = (bf16_t*)(ws + WS_Q); bf16_t* H1B = QB_;
    bf16_t* KB_ = (bf16_t*)(ws + WS_K); bf16_t* UB = KB_;
    bf16_t* VB_ = (bf16_t*)(ws + WS_V); bf16_t* Z1B = VB_;
    bf16_t* ZB = (bf16_t*)(ws + WS_Z); bf16_t* DPB = ZB;
    const int lo = a.ph_lo, hi = a.ph_hi;
#ifdef ONLY_PHASE
#define IN(k) ((k) == ONLY_PHASE && lo <= (k) && (k) < hi)
#else
#define IN(k) (lo <= (k) && (k) < hi)
#endif
#define SEAM(k) do { if (IN(k) && IN((k) + 1)) cg::this_grid().sync(); } while (0)

    if (IN(0)) {
        LAS float* scr = (LAS float*)((LAS unsigned char*)lds + wid * 8448);
        constexpr int I1 = 32 * 256, IO = 32 * 64, IP = 32 * 128, IG1 = 8 * 16, IO2 = 32 * 64;
        constexpr int NITEMS = I1 + IO + IP + 4 * IG1 + IO2;
        for (int it = gw; it < NITEMS; it += NGW) {
            int r = it;
            if (r < I1) { p0_transpose_item(a.w_in, DM, N1F, 256, W1T, scr, r, lane); continue; } r -= I1;
            if (r < IO) { p0_transpose_item(a.w_out, DM, DM, 64, WOT, scr, r, lane); continue; } r -= IO;
            if (r < IP) { p0_transpose_item(a.pw_in, DM, 2 * DM, 128, WPT, scr, r, lane); continue; } r -= IP;
            if (r < 4 * IG1) { const int gq = r / IG1; p0_transpose_item(a.pw_grp + (size_t)gq * 512 * 512, 512, 512, 16, WGT + (size_t)gq * 512 * 512, scr, r % IG1, lane); continue; } r -= 4 * IG1;
            p0_transpose_item(a.pw_out, DM, DM, 64, WO2T, scr, r, lane);
        }
        for (int e = bx * 512 + tid; e < 16 * DM; e += G * 512) { const int k = e >> 4, n = e & 15; const float w = a.w_in[(size_t)k * N1F + N1 + n];
            W1T[(size_t)(N1 + n) * DM + k] = (bf16_t)(cvt_pk_bf16(w, 0.f) & 0xffffu); }
        for (int m = gw; m < M; m += NGW) row_to_bf16(a.x + (size_t)m * DM, H0B + (size_t)m * DM, lane);
        for (int m = gw; m < NMETA; m += NGW) row_to_bf16(a.meta + (size_t)m * DM, MB + (size_t)m * DM, lane);
        for (int e = bx * 512 + tid; e < NB * NH * 768 * 2; e += G * 512) { const int kv = e & 1, r = e >> 1, bh = r / 768, c = r % 768;
            u32x4 z = {0u, 0u, 0u, 0u}; *(u32x4*)((kv ? VB_ : KB_) + ((size_t)bh * SKV + 16) * HD + (size_t)c * 8) = z; }
    }
    SEAM(0);

    if (IN(1)) {
        const int fr = lane & 15, fq = lane >> 4;
        for (int t = gw; t < 513 + 1024; t += NGW) {
            if (t < 513) {
                const f32x4 acc = wave_gemm16(MB, DM, W1T + (size_t)t * 16 * DM, DM, DM, lane);
                const int n = t * 16 + fr;
#pragma unroll
                for (int i = 0; i < 4; ++i) {
                    const int r = 4 * fq + i; PM[(size_t)r * N1F + n] = acc[i];
                    if (n >= 2048 && n < 6144) { const int kv = n >= 4096, cc = n - (kv ? 4096 : 2048), h = cc >> 7, d = cc & 127; const bf16_t v = (bf16_t)(cvt_pk_bf16(acc[i], 0.f) & 0xffffu);
#pragma unroll
                        for (int b = 0; b < NB; ++b) (kv ? VB_ : KB_)[((size_t)(b * NH + h) * SKV + r) * HD + d] = v; }
                    if (n >= N1) { const float lf = logsig_f(acc[i] + a.b_f[fr]);
#pragma unroll
                        for (int b = 0; b < NB; ++b) LOGF[(size_t)(b * NH + fr) * LTOT + r] = lf; }
                }
            } else {
                const int t2 = t - 513;
                const f32x4 acc = wave_gemm16(H0B + (size_t)t2 * 16 * DM, DM, W1T + (size_t)N1 * DM, DM, DM, lane);
                const float bf = a.b_f[fr];
#pragma unroll
                for (int i = 0; i < 4; ++i) { const int row = t2 * 16 + 4 * fq + i, b = row >> 12, ii = row & 4095;
                    LOGF[(size_t)(b * NH + fr) * LTOT + NMETA + ii] = logsig_f(acc[i] + bf); }
            }
        }
        pg8::Gemm g{H0B, W1T, DM, DM, DM, 0}; pg8::StaticOrder S; S.init(M, N1, G, bx);
        pg8::EpiQKVZ E{QB_, KB_, VB_, ZB};
        pg8::gemm_phase<pg8::EpiQKVZ, pg8::StaticOrder, true>((LAS unsigned char*)lds, g, S, E);
    }
    SEAM(1);

    if (IN(2)) {
        for (int task = gw; task < 256; task += NGW) {
            const int h = task >> 4, i = task & 15; const float bf = a.b_f[h];
            const float q0 = PM[(size_t)i * N1F + h * HD + 2 * lane], q1 = PM[(size_t)i * N1F + h * HD + 2 * lane + 1];
            float ci = 0.f; for (int p = 0; p <= i; ++p) ci += logsig_f(PM[(size_t)p * N1F + N1 + h] + bf);
            float cj = 0.f, mx = -1e30f, l = 0.f, o0 = 0.f, o1 = 0.f;
            for (int j = 0; j <= i; ++j) {
                cj += logsig_f(PM[(size_t)j * N1F + N1 + h] + bf);
                const float k0 = PM[(size_t)j * N1F + 2048 + h * HD + 2 * lane], k1 = PM[(size_t)j * N1F + 2048 + h * HD + 2 * lane + 1];
                const float s = wave_sum(q0 * k0 + q1 * k1) * ATT_SCALE + ci - cj;
                const float mn = fmaxf(mx, s), al = __expf(mx - mn), p = __expf(s - mn);
                const float v0 = PM[(size_t)j * N1F + 4096 + h * HD + 2 * lane], v1 = PM[(size_t)j * N1F + 4096 + h * HD + 2 * lane + 1];
                l = l * al + p; o0 = o0 * al + p * v0; o1 = o1 * al + p * v1; mx = mn;
            }
            const float z0 = PM[(size_t)i * N1F + 6144 + h * HD + 2 * lane], z1 = PM[(size_t)i * N1F + 6144 + h * HD + 2 * lane + 1];
            const float rl = 1.0f / l;
            *(unsigned*)(GM + (size_t)i * DM + h * HD + 2 * lane) = cvt_pk_bf16(o0 * rl * silu_f(z0), o1 * rl * silu_f(z1));
        }
        att::attn_phase((char*)lds, QB_, KB_, VB_, ZB, GB, LOGF);
    }
    SEAM(2);

    if (IN(3)) {
        const int fr = lane & 15, fq = lane >> 4;
        for (int t = gw; t < 128; t += NGW) {
            const f32x4 acc = wave_gemm16(GM, DM, WOT + (size_t)t * 16 * DM, DM, DM, lane);
#pragma unroll
            for (int i = 0; i < 4; ++i) { const int r = 4 * fq + i, n = t * 16 + fr; T0M[(size_t)r * DM + n] = ALPHA * a.meta[(size_t)r * DM + n] + acc[i]; }
        }
        pg8::Gemm g{GB, WOT, DM, DM, DM, 0}; pg8::StaticOrder S; S.init(M, DM, G, bx);
        pg8::EpiT0 E{a.x, a.out};
        pg8::gemm_phase<pg8::EpiT0, pg8::StaticOrder, true>((LAS unsigned char*)lds, g, S, E);
    }
    SEAM(3);

    if (IN(4)) {
        for (int m = gw; m < M + NMETA; m += NGW) {
            if (m < M) ln_row(a.out + (size_t)m * DM, a.ln0_g, a.ln0_b, H1B + (size_t)m * DM, nullptr, STATS + 2 * (size_t)m, lane);
            else ln_row(T0M + (size_t)(m - M) * DM, a.ln0_g, a.ln0_b, H1MB + (size_t)(m - M) * DM, nullptr, nullptr, lane);
        }
    }
    SEAM(4);

    if (IN(5)) {
        const int fr = lane & 15, fq = lane >> 4;
        for (int t = gw; t < 128; t += NGW) {
            const f32x4 acc = wave_gemm16(H1MB, DM, WPT + (size_t)t * 16 * DM, DM, DM, lane);
#pragma unroll
            for (int i = 0; i < 4; ++i) UM[(size_t)(4 * fq + i) * DM + t * 16 + fr] = acc[i];
        }
        pg8::Gemm g{H1B, WPT, DM, DM, DM, 0}; pg8::StaticOrder S; S.init(M, 2 * DM, G, bx);
        pg8::EpiSplit2 E{UB, Z1B};
        pg8::gemm_phase<pg8::EpiSplit2, pg8::StaticOrder, true>((LAS unsigned char*)lds, g, S, E);
    }
    SEAM(5);

    if (IN(6)) {
        for (int it = bx * 512 + tid; it < (M / 32) * 256; it += G * 512) {
            const int chunk = it & 255, run = it >> 8, c0 = chunk * 8, gq = c0 >> 9, w = 2 << gq; const float invw = 1.0f / (float)w;
            const int row0 = run * 32, b = row0 >> 12, i0 = row0 & 4095;
            const bf16_t* Ub = UB + (size_t)(b * SEQ) * DM + c0; const float* Um = UM + c0;
            float sum[8];
#pragma unroll
            for (int e = 0; e < 8; ++e) sum[e] = 0.f;
            for (int j = 1; j < w; ++j) { const int i = i0 - j;
                if (i >= 0) { const u32x4 q = *(const u32x4*)(Ub + (size_t)i * DM);
                    sum[0] += bflo(q.x); sum[1] += bfhi(q.x); sum[2] += bflo(q.y); sum[3] += bfhi(q.y); sum[4] += bflo(q.z); sum[5] += bfhi(q.z); sum[6] += bflo(q.w); sum[7] += bfhi(q.w); }
                else { const f32x4 p0 = *(const f32x4*)(Um + (size_t)(16 + i) * DM), p1 = *(const f32x4*)(Um + (size_t)(16 + i) * DM + 4);
                    sum[0] += p0[0]; sum[1] += p0[1]; sum[2] += p0[2]; sum[3] += p0[3]; sum[4] += p1[0]; sum[5] += p1[1]; sum[6] += p1[2]; sum[7] += p1[3]; } }
#pragma unroll 4
            for (int s = 0; s < 32; ++s) { const int i = i0 + s;
                const u32x4 q = *(const u32x4*)(Ub + (size_t)i * DM);
                float f[8] = {bflo(q.x), bfhi(q.x), bflo(q.y), bfhi(q.y), bflo(q.z), bfhi(q.z), bflo(q.w), bfhi(q.w)};
                float d[8];
#pragma unroll
                for (int e = 0; e < 8; ++e) { sum[e] += f[e]; d[e] = sum[e] * invw - f[e]; }
                u32x4 o; o.x = cvt_pk_bf16(d[0], d[1]); o.y = cvt_pk_bf16(d[2], d[3]); o.z = cvt_pk_bf16(d[4], d[5]); o.w = cvt_pk_bf16(d[6], d[7]);
                *(u32x4*)(DPB + (size_t)(row0 + s) * DM + c0) = o;
                const int io = i - w + 1;
                if (io >= 0) { const u32x4 r = *(const u32x4*)(Ub + (size_t)io * DM);
                    sum[0] -= bflo(r.x); sum[1] -= bfhi(r.x); sum[2] -= bflo(r.y); sum[3] -= bfhi(r.y); sum[4] -= bflo(r.z); sum[5] -= bfhi(r.z); sum[6] -= bflo(r.w); sum[7] -= bfhi(r.w); }
                else { const f32x4 p0 = *(const f32x4*)(Um + (size_t)(16 + io) * DM), p1 = *(const f32x4*)(Um + (size_t)(16 + io) * DM + 4);
                    sum[0] -= p0[0]; sum[1] -= p0[1]; sum[2] -= p0[2]; sum[3] -= p0[3]; sum[4] -= p1[0]; sum[5] -= p1[1]; sum[6] -= p1[2]; sum[7] -= p1[3]; } }
        }
    }
    SEAM(6);

    if (IN(7)) {
        pg8::Gemm g{DPB, WGT, DM, 512, 512, 2}; pg8::StaticOrder S; S.init(M, DM, G, bx);
        pg8::EpiGate E{Z1B, a.p_scale, EB};
        pg8::gemm_phase<pg8::EpiGate, pg8::StaticOrder, true>((LAS unsigned char*)lds, g, S, E);
    }
    SEAM(7);

    if (IN(8)) {
        pg8::Gemm g{EB, WO2T, DM, DM, DM, 0}; pg8::StaticOrder S; S.init(M, DM, G, bx);
        pg8::EpiT1 E{a.out, STATS, a.ln0_g, a.ln0_b};
        pg8::gemm_phase<pg8::EpiT1, pg8::StaticOrder, true>((LAS unsigned char*)lds, g, S, E);
    }
    SEAM(8);

    if (IN(9)) {
        for (int m = gw; m < M; m += NGW) ln_row(a.out + (size_t)m * DM, a.ln1_g, a.ln1_b, nullptr, a.out + (size_t)m * DM, nullptr, lane);
    }
#undef IN
#undef SEAM
}

extern "C" void kernel_launch(void* const* d_in, const int* in_sizes, int n_in, void* d_out, int out_size, void* d_ws, size_t ws_size, hipStream_t stream) {
    static int grid = 0;
    if (grid == 0) {
        if (n_in != 13 || in_sizes[0] != M * DM || out_size != M * DM || ws_size < WS_END) { fprintf(stderr, "kernel_launch: shape/workspace mismatch (n_in %d, in0 %d, out %d, ws %zu)\n", n_in, n_in > 0 ? in_sizes[0] : -1, out_size, ws_size); grid = -1; return; }
        int dev = 0, cus = 0, per_cu = 0;
        (void)hipGetDevice(&dev); (void)hipDeviceGetAttribute(&cus, hipDeviceAttributeMultiprocessorCount, dev);
        if (hipFuncSetAttribute((const void*)fwd, hipFuncAttributeMaxDynamicSharedMemorySize, LDS_BYTES) != hipSuccess) { fprintf(stderr, "kernel_launch: hipFuncSetAttribute failed\n"); grid = -1; return; }
        if (hipOccupancyMaxActiveBlocksPerMultiprocessor(&per_cu, (const void*)fwd, 512, LDS_BYTES) != hipSuccess || per_cu < 1) { fprintf(stderr, "kernel_launch: occupancy query says %d\n", per_cu); per_cu = 1; }
        (void)hipGetLastError();
        grid = cus * 1;
        if (grid <= 0) grid = 256;
    }
    if (grid < 0) return;
    Args a{};
    a.x = (const float*)d_in[0]; a.meta = (const float*)d_in[1]; a.w_in = (const float*)d_in[2]; a.b_f = (const float*)d_in[3]; a.w_out = (const float*)d_in[4];
    a.ln0_g = (const float*)d_in[5]; a.ln0_b = (const float*)d_in[6]; a.pw_in = (const float*)d_in[7]; a.pw_grp = (const float*)d_in[8]; a.p_scale = (const float*)d_in[9];
    a.pw_out = (const float*)d_in[10]; a.ln1_g = (const float*)d_in[11]; a.ln1_b = (const float*)d_in[12];
    a.out = (float*)d_out; a.ws = (unsigned char*)d_ws;
#if MK_N_LAUNCHES == 1
    a.ph_lo = 0; a.ph_hi = N_PHASES;
    void* args[] = {&a};
    hipError_t e = hipLaunchCooperativeKernel((const void*)fwd, dim3(grid), dim3(512), args, LDS_BYTES, stream);
    if (e != hipSuccess) fprintf(stderr, "kernel_launch: cooperative launch failed: %s (grid %d)\n", hipGetErrorString(e), grid);
#else
    for (int p = 0; p < N_PHASES; ++p) { a.ph_lo = p; a.ph_hi = p + 1; hipLaunchKernelGGL(fwd, dim3(grid), dim3(512), LDS_BYTES, stream, a); }
#endif
}
```

```cpp
#include <hip/hip_runtime.h>
#include <hip/hip_cooperative_groups.h>
#include <cstdio>
#include <cstdint>
namespace cg = cooperative_groups;

#ifndef MK_N_LAUNCHES
#define MK_N_LAUNCHES 1
#endif

#ifndef PROBE_DUP
#define PROBE_DUP -1
#endif
#define LAS __attribute__((address_space(3)))
typedef unsigned short bf16_t;
typedef short bf16x8 __attribute__((ext_vector_type(8)));
typedef short s16x4 __attribute__((ext_vector_type(4)));
typedef float f32x4 __attribute__((ext_vector_type(4)));
typedef float f32x2 __attribute__((ext_vector_type(2)));
typedef float f32x16 __attribute__((ext_vector_type(16)));
typedef unsigned u32x4 __attribute__((ext_vector_type(4)));
typedef unsigned u32x2 __attribute__((ext_vector_type(2)));

constexpr int DM = 2048, NB = 4, SEQ = 4096, NMETA = 16, NH = 16, HD = 128;
constexpr int M = NB * SEQ;
constexpr int LTOT = SEQ + NMETA;
constexpr int SKV = SEQ + 64;
constexpr int N1 = 8192, N1F = 8208;
constexpr float ALPHA = 1.4142135623730951f;
constexpr float LN_EPS = 1e-5f;
constexpr float ATT_SCALE = 0.08838834764831845f;

constexpr size_t MiB = 1u << 20;
constexpr size_t WS_LOGF = 1 * MiB;
constexpr size_t WS_MB = 3 * MiB;
constexpr size_t WS_PM = 3 * MiB + 256 * 1024;
constexpr size_t WS_GM = 4 * MiB;
constexpr size_t WS_T0M = 4 * MiB + 64 * 1024;
constexpr size_t WS_H1MB = 4 * MiB + 192 * 1024;
constexpr size_t WS_UM = 4 * MiB + 256 * 1024;
constexpr size_t WS_STATS = 5 * MiB;
constexpr size_t WS_W1T = 8 * MiB;
constexpr size_t WS_WOT = 41 * MiB;
constexpr size_t WS_WPT = 49 * MiB;
constexpr size_t WS_WGT = 65 * MiB;
constexpr size_t WS_WO2T = 67 * MiB;
constexpr size_t WS_H0B = 76 * MiB;
constexpr size_t WS_Q = 140 * MiB;
constexpr size_t WS_K = 204 * MiB;
constexpr size_t WS_V = 269 * MiB;
constexpr size_t WS_Z = 334 * MiB;
constexpr size_t WS_END = 398 * MiB;

constexpr int LDS_BYTES = 135168;

__device__ __forceinline__ unsigned cvt_pk_bf16(float lo, float hi) { unsigned r; asm volatile("v_cvt_pk_bf16_f32 %0, %1, %2" : "=v"(r) : "v"(lo), "v"(hi)); return r; }
__device__ __forceinline__ float bf2f(unsigned short v) { return __uint_as_float((unsigned)v << 16); }
__device__ __forceinline__ float bflo(unsigned w) { return __uint_as_float(w << 16); }
__device__ __forceinline__ float bfhi(unsigned w) { return __uint_as_float(w & 0xffff0000u); }
__device__ __forceinline__ float silu_f(float z) { return z * __builtin_amdgcn_rcpf(1.0f + __expf(-z)); }
__device__ __forceinline__ float logsig_f(float x) { return fminf(x, 0.f) - log1pf(expf(-fabsf(x))); }
__device__ __forceinline__ float wave_sum(float v) {
#pragma unroll
    for (int o = 1; o < 64; o <<= 1) v += __shfl_xor(v, o);
    return v;
}
#define LDS_WAIT() asm volatile("s_waitcnt lgkmcnt(0)" ::: "memory")

namespace pg8 {
constexpr int BM = 256, BK = 64, HALF = 128, HTB = HALF * BK * 2, STAGE_BYTES = 8 * HTB, NXCD = 8, WGM = 8;
__host__ __device__ __forceinline__ int lds_byte(int r, int c) { const int st = (r >> 4) * 2 + (c >> 5), rr = r & 15, cc = c & 31, ob = rr * 64 + cc * 2; return st * 1024 + (ob ^ (((ob >> 9) & 1) << 5)); }
__host__ __device__ __forceinline__ void stage_rc(int b, int& R, int& C) { const int st = b / 1024, sb = b % 1024, swz = sb ^ (((sb >> 9) & 1) << 5); R = (st >> 1) * 16 + swz / 64; C = (st & 1) * 32 + (swz % 64) / 2; }
__host__ __device__ __forceinline__ int perm32(int rho) { const int n = rho >> 4, i = rho & 15; return 8 * (i >> 2) + 4 * n + (i & 3); }

struct Unit { int pm, pn; };
struct Gemm { const bf16_t* A; const bf16_t* Bt; int lda, ldb, K, grp; };

struct StaticOrder {
    int nM, nN, nwg, G, c;
    __host__ __device__ void init(int M_, int N_, int G_, int c_) { nM = M_ / BM; nN = N_ / BM; nwg = nM * nN; G = G_; c = c_; }
    __host__ __device__ bool next(int i, Unit& u) const {
        const long L = (long)i * G + c; if (L >= nwg) return false;
        int wgid = (int)L; { const int q = nwg / NXCD, r = nwg % NXCD, xcd = wgid % NXCD, off = wgid / NXCD; wgid = (xcd < r ? xcd * (q + 1) : r * (q + 1) + (xcd - r) * q) + off; }
        const int nig = WGM * nN, gid = wgid / nig, fm = gid * WGM, gsz = (nM - fm) < WGM ? (nM - fm) : WGM;
        u.pm = fm + ((wgid % nig) % gsz); u.pn = (wgid % nig) / gsz; return true;
    }
};

template <class Epi, class Sched, bool ALIGN_EPI>
__device__ __forceinline__ void gemm_phase(LAS unsigned char* lds, const Gemm g, const Sched& S, const Epi& E) {
    const int tid = threadIdx.x, wid = __builtin_amdgcn_readfirstlane(tid >> 6), lane = tid & 63, wr = wid >> 2, wc = wid & 3, fr = lane & 15, fq = lane >> 4;
    const int K = g.K, nt = K / BK;
    unsigned voffA[2], voffB[2];
#pragma unroll
    for (int i = 0; i < 2; ++i) { int R, C; stage_rc(tid * 16 + i * 8192, R, C); const int Rb = Epi::PERM ? ((R & ~31) + perm32(R & 31)) : R;
        voffA[i] = (unsigned)(R * g.lda + C) * 2u; voffB[i] = (unsigned)(Rb * g.ldb + C) * 2u; }
    const size_t kstep = (size_t)(BK * 2);
    const size_t hA = (size_t)HALF * g.lda * 2, hB = (size_t)HALF * g.ldb * 2;
    const unsigned ldsw = (unsigned)wid * 1024u;
    const int aoff = lds_byte(wr * 64 + fr, fq * 8), boff = lds_byte(wc * 32 + fr, fq * 8);
#define PG8_SA(b, h) (((b) * 2 + (h)) * HTB)
#define PG8_SB(b, h) ((4 + (b) * 2 + (h)) * HTB)
#define PG8_STAGE(bufoff, gbase, voff) do { _Pragma("unroll") for (int _i = 0; _i < 2; ++_i) \
        __builtin_amdgcn_global_load_lds((const unsigned*)((const char*)(gbase) + (voff)[_i]), (LAS unsigned*)(lds + (bufoff) + ldsw + _i * 8192), 16, 0, 0); } while (0)
#define PG8_LDA(dst, b, h) do { _Pragma("unroll") for (int m = 0; m < 4; ++m) _Pragma("unroll") for (int k = 0; k < 2; ++k) dst[m][k] = *(const LAS bf16x8*)(lds + PG8_SA(b, h) + aoff + m * 2048 + k * 1024); } while (0)
#define PG8_LDB(dst, b, h) do { _Pragma("unroll") for (int n = 0; n < 2; ++n) _Pragma("unroll") for (int k = 0; k < 2; ++k) dst[n][k] = *(const LAS bf16x8*)(lds + PG8_SB(b, h) + boff + n * 2048 + k * 1024); } while (0)
#define PG8_MMA(ai, bj, At, Bt) do { __builtin_amdgcn_s_setprio(1); _Pragma("unroll") for (int m = 0; m < 4; ++m) _Pragma("unroll") for (int n = 0; n < 2; ++n) _Pragma("unroll") for (int k = 0; k < 2; ++k) \
        acc[ai][bj][m][n] = __builtin_amdgcn_mfma_f32_16x16x32_bf16(Bt[n][k], At[m][k], acc[ai][bj][m][n], 0, 0, 0); __builtin_amdgcn_s_setprio(0); } while (0)
#define PG8_WAIT_V(n) asm volatile("s_waitcnt vmcnt(" #n ")" ::: "memory")
#define PG8_WAIT_L(n) asm volatile("s_waitcnt lgkmcnt(" #n ")" ::: "memory")
#define PG8_BAR __builtin_amdgcn_s_barrier()
#define PG8_SCHED __builtin_amdgcn_sched_barrier(0)
#define PG8_UA(u) ((const char*)g.A + (size_t)(u).pm * 2 * hA + (g.grp ? (size_t)((u).pn / g.grp) * (size_t)K * 2 : (size_t)0))
#define PG8_UB(u) ((const char*)g.Bt + (size_t)(u).pn * 2 * hB)
    Unit cur, nxt; int ui = 0;
    if (!S.next(0, cur)) return;
    f32x4 acc[2][2][4][2];
#pragma unroll
    for (int a = 0; a < 2; ++a)
#pragma unroll
        for (int b = 0; b < 2; ++b)
#pragma unroll
            for (int m = 0; m < 4; ++m)
#pragma unroll
                for (int n = 0; n < 2; ++n) acc[a][b][m][n] = (f32x4){0.f, 0.f, 0.f, 0.f};
    bf16x8 At[4][2], B0[2][2], B1[2][2];
    const char* cA = PG8_UA(cur); const char* cB = PG8_UB(cur);
    PG8_STAGE(PG8_SB(0, 0), cB, voffB); PG8_STAGE(PG8_SB(0, 1), cB + hB, voffB); PG8_STAGE(PG8_SA(0, 0), cA, voffA); PG8_STAGE(PG8_SA(0, 1), cA + hA, voffA);
    if (wr == 1) PG8_BAR;
    PG8_WAIT_V(2); PG8_BAR;
    PG8_STAGE(PG8_SB(1, 0), cB + kstep, voffB); PG8_STAGE(PG8_SA(1, 0), cA + kstep, voffA); PG8_STAGE(PG8_SB(1, 1), cB + hB + kstep, voffB);
    PG8_WAIT_V(6); PG8_BAR;
    for (;;) {
        const bool has_next = S.next(ui + 1, nxt);
        const char* nA = has_next ? PG8_UA(nxt) : cA; const char* nB = has_next ? PG8_UB(nxt) : cB;
        for (int t = 0; t < nt; t += 2) {
            const bool last = (t == nt - 2);
            const char* a1 = cA + (size_t)(t + 1) * kstep;
            const char* a2 = last ? nA : cA + (size_t)(t + 2) * kstep; const char* b2 = last ? nB : cB + (size_t)(t + 2) * kstep;
            const char* a3 = a2 + kstep; const char* b3 = b2 + kstep;
            PG8_LDB(B0, 0, 0); PG8_LDB(B1, 0, 1); PG8_SCHED; PG8_LDA(At, 0, 0); PG8_STAGE(PG8_SA(1, 1), a1 + hA, voffA);
            PG8_WAIT_V(8); PG8_WAIT_L(0); PG8_BAR; PG8_MMA(0, 0, At, B0); PG8_MMA(0, 1, At, B1); PG8_BAR; PG8_SCHED;
            PG8_LDA(At, 0, 1); PG8_STAGE(PG8_SB(0, 0), b2, voffB); PG8_STAGE(PG8_SB(0, 1), b2 + hB, voffB); PG8_STAGE(PG8_SA(0, 0), a2, voffA);
            PG8_WAIT_V(8); PG8_WAIT_L(0); PG8_BAR; PG8_MMA(1, 0, At, B0); PG8_MMA(1, 1, At, B1); PG8_BAR; PG8_SCHED;
            PG8_LDB(B0, 1, 0); PG8_LDB(B1, 1, 1); PG8_SCHED; PG8_LDA(At, 1, 0); PG8_STAGE(PG8_SA(0, 1), a2 + hA, voffA);
            PG8_WAIT_V(8); PG8_WAIT_L(0); PG8_BAR; PG8_MMA(0, 0, At, B0); PG8_MMA(0, 1, At, B1); PG8_BAR; PG8_SCHED;
            PG8_LDA(At, 1, 1); PG8_STAGE(PG8_SB(1, 0), b3, voffB); PG8_STAGE(PG8_SB(1, 1), b3 + hB, voffB); PG8_STAGE(PG8_SA(1, 0), a3, voffA);
            PG8_WAIT_V(8); PG8_WAIT_L(0); PG8_BAR; PG8_MMA(1, 0, At, B0); PG8_MMA(1, 1, At, B1); PG8_BAR; PG8_SCHED;
        }
        if constexpr (ALIGN_EPI) { if (wr == 0) PG8_BAR; }
        E(acc, cur, wr, wc, fr, fq);
        if (!has_next) break;
#pragma unroll
        for (int a = 0; a < 2; ++a)
#pragma unroll
            for (int b = 0; b < 2; ++b)
#pragma unroll
                for (int m = 0; m < 4; ++m)
#pragma unroll
                    for (int n = 0; n < 2; ++n) acc[a][b][m][n] = (f32x4){0.f, 0.f, 0.f, 0.f};
        cur = nxt; cA = nA; cB = nB; ++ui;
        if constexpr (ALIGN_EPI) { if (wr == 1) PG8_BAR; }
    }
    PG8_WAIT_V(0);
    if constexpr (!ALIGN_EPI) { if (wr == 0) PG8_BAR; }
    PG8_BAR;
#undef PG8_SA
#undef PG8_SB
#undef PG8_STAGE
#undef PG8_LDA
#undef PG8_LDB
#undef PG8_MMA
#undef PG8_WAIT_V
#undef PG8_WAIT_L
#undef PG8_BAR
#undef PG8_SCHED
#undef PG8_UA
#undef PG8_UB
}

__device__ __forceinline__ u32x4 pack8f(f32x4 a, f32x4 b) { u32x4 w; w.x = cvt_pk_bf16(a[0], a[1]); w.y = cvt_pk_bf16(a[2], a[3]); w.z = cvt_pk_bf16(b[0], b[1]); w.w = cvt_pk_bf16(b[2], b[3]); return w; }

struct EpiQKVZ {
    static constexpr bool PERM = true;
    bf16_t *Q, *Kb, *Vb, *Z;
    __device__ __forceinline__ void operator()(const f32x4 (&acc)[2][2][4][2], const Unit& u, int wr, int wc, int fr, int fq) const {
        const int t = u.pn >> 3, hbase = (u.pn & 7) * 2, d = wc * 32 + 8 * fq;
#pragma unroll
        for (int ai = 0; ai < 2; ++ai)
#pragma unroll
            for (int m = 0; m < 4; ++m) {
                const int row = u.pm * BM + ai * HALF + wr * 64 + m * 16 + fr, b = row >> 12, i = row & 4095;
#pragma unroll
                for (int bj = 0; bj < 2; ++bj) {
                    const int h = hbase + bj; bf16_t* p;
                    if (t == 0) p = Q + ((size_t)((b * NH + h) * SEQ + i)) * HD + d;
                    else if (t == 3) p = Z + (size_t)row * DM + h * HD + d;
                    else p = (t == 1 ? Kb : Vb) + ((size_t)((b * NH + h) * SKV + 64 + i)) * HD + d;
                    *(u32x4*)p = pack8f(acc[ai][bj][m][0], acc[ai][bj][m][1]);
                }
            }
    }
};
struct EpiSplit2 {
    static constexpr bool PERM = true;
    bf16_t *O0, *O1;
    __device__ __forceinline__ void operator()(const f32x4 (&acc)[2][2][4][2], const Unit& u, int wr, int wc, int fr, int fq) const {
        bf16_t* base = (u.pn < 8 ? O0 : O1) + (u.pn & 7) * BM + wc * 32 + 8 * fq;
#pragma unroll
        for (int ai = 0; ai < 2; ++ai)
#pragma unroll
            for (int m = 0; m < 4; ++m) {
                const int row = u.pm * BM + ai * HALF + wr * 64 + m * 16 + fr;
#pragma unroll
                for (int bj = 0; bj < 2; ++bj) *(u32x4*)(base + (size_t)row * DM + bj * HALF) = pack8f(acc[ai][bj][m][0], acc[ai][bj][m][1]);
            }
    }
};
struct EpiT0 {
    static constexpr bool PERM = false;
    const float* X; float* O;
    __device__ __forceinline__ void operator()(const f32x4 (&acc)[2][2][4][2], const Unit& u, int wr, int wc, int fr, int fq) const {
        const int col0 = u.pn * BM + wc * 32 + 4 * fq;
#pragma unroll
        for (int ai = 0; ai < 2; ++ai)
#pragma unroll
            for (int m = 0; m < 4; ++m) {
                const size_t off = (size_t)(u.pm * BM + ai * HALF + wr * 64 + m * 16 + fr) * DM + col0;
#pragma unroll
                for (int bj = 0; bj < 2; ++bj)
#pragma unroll
                    for (int n = 0; n < 2; ++n) { const f32x4 xv = *(const f32x4*)(X + off + bj * HALF + n * 16); *(f32x4*)(O + off + bj * HALF + n * 16) = xv * ALPHA + acc[ai][bj][m][n]; }
            }
    }
};
struct EpiGate {
    static constexpr bool PERM = true;
    const bf16_t* Z1; const float* scale; bf16_t* O;
    __device__ __forceinline__ void operator()(const f32x4 (&acc)[2][2][4][2], const Unit& u, int wr, int wc, int fr, int fq) const {
        const int col0 = u.pn * BM + wc * 32 + 8 * fq;
        f32x4 sv[2][2];
#pragma unroll
        for (int bj = 0; bj < 2; ++bj) { sv[bj][0] = *(const f32x4*)(scale + col0 + bj * HALF); sv[bj][1] = *(const f32x4*)(scale + col0 + bj * HALF + 4); }
#pragma unroll
        for (int ai = 0; ai < 2; ++ai)
#pragma unroll
            for (int m = 0; m < 4; ++m) {
                const size_t off = (size_t)(u.pm * BM + ai * HALF + wr * 64 + m * 16 + fr) * DM + col0;
#pragma unroll
                for (int bj = 0; bj < 2; ++bj) {
                    const u32x4 zw = *(const u32x4*)(Z1 + off + bj * HALF);
                    f32x4 v0 = acc[ai][bj][m][0] * sv[bj][0], v1 = acc[ai][bj][m][1] * sv[bj][1];
                    v0[0] *= silu_f(bflo(zw.x)); v0[1] *= silu_f(bfhi(zw.x)); v0[2] *= silu_f(bflo(zw.y)); v0[3] *= silu_f(bfhi(zw.y));
                    v1[0] *= silu_f(bflo(zw.z)); v1[1] *= silu_f(bfhi(zw.z)); v1[2] *= silu_f(bflo(zw.w)); v1[3] *= silu_f(bfhi(zw.w));
                    *(u32x4*)(O + off + bj * HALF) = pack8f(v0, v1);
                }
            }
    }
};
struct EpiT1 {
    static constexpr bool PERM = false;
    float* T; const float* stats; const float* g; const float* bb;
    __device__ __forceinline__ void operator()(const f32x4 (&acc)[2][2][4][2], const Unit& u, int wr, int wc, int fr, int fq) const {
        const int col0 = u.pn * BM + wc * 32 + 4 * fq;
        f32x4 gv[2][2], bv[2][2];
#pragma unroll
        for (int bj = 0; bj < 2; ++bj)
#pragma unroll
            for (int n = 0; n < 2; ++n) { gv[bj][n] = *(const f32x4*)(g + col0 + bj * HALF + n * 16); bv[bj][n] = *(const f32x4*)(bb + col0 + bj * HALF + n * 16); }
#pragma unroll
        for (int ai = 0; ai < 2; ++ai)
#pragma unroll
            for (int m = 0; m < 4; ++m) {
                const int row = u.pm * BM + ai * HALF + wr * 64 + m * 16 + fr;
                const f32x2 st = *(const f32x2*)(stats + 2 * (size_t)row);
                const size_t off = (size_t)row * DM + col0;
#pragma unroll
                for (int bj = 0; bj < 2; ++bj)
#pragma unroll
                    for (int n = 0; n < 2; ++n) { const f32x4 tv = *(const f32x4*)(T + off + bj * HALF + n * 16);
                        const f32x4 h1 = (tv - st.x) * st.y * gv[bj][n] + bv[bj][n];
                        *(f32x4*)(T + off + bj * HALF + n * 16) = h1 * ALPHA + acc[ai][bj][m][n]; }
            }
    }
};
}

namespace att {
constexpr int D = 128, NW = 8, QBLK = 32, KVBLK = 64, QB = 256;
constexpr int SHM_V = KVBLK * D * 2, SHM_K = KVBLK * D * 2;
constexpr int OFF_WS = 2 * SHM_V + 2 * SHM_K;
constexpr int OFF_NBK = OFF_WS + NW * 64 * 4;
constexpr int OFF_SCAN = OFF_NBK + SKV * 4;
constexpr int ATT_LDS = OFF_SCAN + 64;
constexpr float SCALE = ATT_SCALE;
constexpr float THR = 8.f;
#define KSWZ(row, colB) ((row) * 256 + ((colB) ^ (((row) & 7) << 4)))
#define SBAR() __builtin_amdgcn_sched_barrier(0)
__device__ __forceinline__ int v_st(int k, int c) { const int kk = (k & ~0xC) | ((k & 4) << 1) | ((k & 8) >> 1); return ((kk >> 3) * 4 + (c >> 5)) * 512 + ((kk & 7) * 32 + (c & 31)) * 2; }
__device__ __forceinline__ int v_rd_base(int lane) { return ((lane & 3) << 3) | (((lane >> 2) & 3) << 6) | (((lane >> 4) & 1) << 5) | (((lane >> 5) & 1) << 8); }
constexpr int v_rd_off(int d0, int ks, int half) { return d0 * 512 + ks * 4096 + half * 2048; }
__device__ __forceinline__ int crow(int r, int hi) { return (r & 3) + 8 * (r >> 2) + 4 * hi; }
__device__ __forceinline__ bf16x8 load8(const bf16_t* p) { return *reinterpret_cast<const bf16x8*>(p); }
__device__ __forceinline__ void mask_tile(f32x16& p0, f32x16& p1, int dq) {
    const float NEG = -__builtin_inff();
#pragma unroll
    for (int r = 0; r < 16; ++r) {
        const int c = (r & 3) + 8 * (r >> 2);
        if (dq - c < 0) p0[r] = NEG;
        if (dq - c - 32 < 0) p1[r] = NEG;
    }
}
__device__ __forceinline__ void partialSM(f32x16& p0, f32x16& p1, float& m_reg, float& mn, float& alpha) {
    float pmax = p0[0];
#pragma unroll
    for (int r = 1; r < 16; ++r) pmax = fmaxf(pmax, p0[r]);
#pragma unroll
    for (int r = 0; r < 16; ++r) pmax = fmaxf(pmax, p1[r]);
    { auto rr = __builtin_amdgcn_permlane32_swap(__float_as_uint(pmax), __float_as_uint(pmax), false, false);
      pmax = fmaxf(__uint_as_float(rr[0]), __uint_as_float(rr[1])); }
    constexpr float C2 = 1.4426950408889634f * SCALE;
    if (__builtin_expect(__all((pmax - m_reg) * SCALE <= THR), 1)) { mn = m_reg; alpha = 1.f; }
    else { mn = fmaxf(m_reg, pmax); alpha = __builtin_amdgcn_exp2f((m_reg - mn) * C2); m_reg = mn; }
    const float mnL = -mn * C2;
#pragma unroll
    for (int r = 0; r < 16; ++r) p0[r] = fmaf(p0[r], C2, mnL);
#pragma unroll
    for (int r = 0; r < 16; ++r) p1[r] = fmaf(p1[r], C2, mnL);
#pragma unroll
    for (int r = 0; r < 16; ++r) p0[r] = __builtin_amdgcn_exp2f(p0[r]);
}
__device__ __forceinline__ void finishSM(f32x16& p0, f32x16& p1, float alpha, float& l_reg, bf16x8& pa0, bf16x8& pa1, bf16x8& pa2, bf16x8& pa3) {
#pragma unroll
    for (int r = 0; r < 16; ++r) p1[r] = __builtin_amdgcn_exp2f(p1[r]);
    float ps = 0;
#pragma unroll
    for (int r = 0; r < 16; ++r) ps += p0[r];
#pragma unroll
    for (int r = 0; r < 16; ++r) ps += p1[r];
    { auto rr = __builtin_amdgcn_permlane32_swap(__float_as_uint(ps), __float_as_uint(ps), false, false);
      ps = __uint_as_float(rr[0]) + __uint_as_float(rr[1]); }
    l_reg = l_reg * alpha + ps;
#define PK4(P, B_, OUT) do { unsigned a0 = cvt_pk_bf16(P[B_+0], P[B_+1]), a1 = cvt_pk_bf16(P[B_+2], P[B_+3]);                          \
        unsigned b0 = cvt_pk_bf16(P[B_+4], P[B_+5]), b1 = cvt_pk_bf16(P[B_+6], P[B_+7]);                                             \
        auto r0 = __builtin_amdgcn_permlane32_swap(a0, b0, false, false); auto r1 = __builtin_amdgcn_permlane32_swap(a1, b1, false, false); \
        u32x4 w = {r0[0], r1[0], r0[1], r1[1]}; OUT = *reinterpret_cast<bf16x8*>(&w); } while (0)
    PK4(p0, 0, pa0); PK4(p0, 8, pa1); PK4(p1, 0, pa2); PK4(p1, 8, pa3);
#undef PK4
}
template <int KB>
__device__ __forceinline__ void qkt(f32x16& p0, f32x16& p1, const char* K_lds, const float* nbk_t, int r32, int hi, const bf16x8* qr) {
    const f32x4* bp = (const f32x4*)(nbk_t + 4 * hi);
#pragma unroll
    for (int g = 0; g < 4; ++g) { const f32x4 a = bp[2 * g], b = bp[8 + 2 * g];
        p0[4 * g] = a[0]; p0[4 * g + 1] = a[1]; p0[4 * g + 2] = a[2]; p0[4 * g + 3] = a[3];
        p1[4 * g] = b[0]; p1[4 * g + 1] = b[1]; p1[4 * g + 2] = b[2]; p1[4 * g + 3] = b[3]; }
    const char* kb[4];
#pragma unroll
    for (int dd = 0; dd < 4; ++dd) kb[dd] = K_lds + KB * SHM_K + KSWZ(r32, (dd * 16 + hi * 8) * 2);
#pragma unroll
    for (int d0 = 0; d0 < 8; ++d0) { const char* a = kb[d0 & 3] + (d0 >> 2) * 128;
        bf16x8 b0 = *reinterpret_cast<const bf16x8*>(a);
        bf16x8 b1 = *reinterpret_cast<const bf16x8*>(a + 32 * 256);
        p0 = __builtin_amdgcn_mfma_f32_32x32x16_bf16(b0, qr[d0], p0, 0, 0, 0);
        p1 = __builtin_amdgcn_mfma_f32_32x32x16_bf16(b1, qr[d0], p1, 0, 0, 0); }
}
template <int VB>
__device__ __forceinline__ void pv_tile(f32x16* o, int vb0, bf16x8 pa0, bf16x8 pa1, bf16x8 pa2, bf16x8 pa3) {
#define TRRD(dst, off) asm volatile("ds_read_b64_tr_b16 %0, %1 offset:%2" : "=&v"(dst) : "v"(vb0), "i"(off) : "memory")
#define PV_D0(d0) do { s16x4 l0, l1, l2, l3, h0, h1, h2, h3; constexpr int b_ = VB * SHM_V + v_rd_off(d0, 0, 0); \
        TRRD(l0, b_); TRRD(h0, b_ + 2048); TRRD(l1, b_ + 4096); TRRD(h1, b_ + 6144); TRRD(l2, b_ + 8192); TRRD(h2, b_ + 10240); TRRD(l3, b_ + 12288); TRRD(h3, b_ + 14336); \
        asm volatile("s_waitcnt lgkmcnt(0)" ::: "memory"); SBAR();   \
        o[d0] = __builtin_amdgcn_mfma_f32_32x32x16_bf16(pa0, (bf16x8){l0[0], l0[1], l0[2], l0[3], h0[0], h0[1], h0[2], h0[3]}, o[d0], 0, 0, 0);   \
        o[d0] = __builtin_amdgcn_mfma_f32_32x32x16_bf16(pa1, (bf16x8){l1[0], l1[1], l1[2], l1[3], h1[0], h1[1], h1[2], h1[3]}, o[d0], 0, 0, 0);   \
        o[d0] = __builtin_amdgcn_mfma_f32_32x32x16_bf16(pa2, (bf16x8){l2[0], l2[1], l2[2], l2[3], h2[0], h2[1], h2[2], h2[3]}, o[d0], 0, 0, 0);   \
        o[d0] = __builtin_amdgcn_mfma_f32_32x32x16_bf16(pa3, (bf16x8){l3[0], l3[1], l3[2], l3[3], h3[0], h3[1], h3[2], h3[3]}, o[d0], 0, 0, 0); } while (0)
    PV_D0(0); PV_D0(1); PV_D0(2); PV_D0(3);
#undef PV_D0
#undef TRRD
}

struct BlockRef { const bf16_t* Q; const bf16_t* K; int P0; int row0; int h; };
struct Seam { bf16x8 qr[8]; bf16x8 st_v0, st_v1, st_k0, st_k1; };
constexpr size_t VDELTA = (WS_V - WS_K) / 2;
__device__ __forceinline__ bf16x8 load8o(const bf16_t* base, unsigned byteoff) { return *reinterpret_cast<const bf16x8*>((const char*)base + byteoff); }
#define ROWB(k0, rr) (rowoff + (unsigned)(((k0) + (rr)) * D * 2))
#define VMW() asm volatile("s_waitcnt vmcnt(0)" ::: "memory")
#define VMWN(n) asm volatile("s_waitcnt vmcnt(%0)" :: "i"(n) : "memory")
#define SLOAD_H(Kp, k0) do { S.st_v0 = load8o((Kp) + VDELTA, ROWB(k0, 0)); S.st_v1 = load8o((Kp) + VDELTA, ROWB(k0, 32));              \
                         S.st_k0 = load8o(Kp, ROWB(k0, 0)); S.st_k1 = load8o(Kp, ROWB(k0, 32)); } while (0)
#define SWRITE_HK(bf) do { *(bf16x8*)(K_lds + (bf) * SHM_K + kws) = S.st_k0; *(bf16x8*)(K_lds + (bf) * SHM_K + kws + 32 * 256) = S.st_k1; } while (0)
#define SWRITE_HV(bf) do { *(bf16x8*)(V_lds + (bf) * SHM_V + vst0) = S.st_v0; *(bf16x8*)(V_lds + (bf) * SHM_V + vst1) = S.st_v1; } while (0)
#define SWRITE_H(bf) do { SWRITE_HV(bf); SWRITE_HK(bf); } while (0)
__device__ __forceinline__ void prime(const BlockRef& cur, char* lds, Seam& S) {
    const int tid = threadIdx.x, wid = __builtin_amdgcn_readfirstlane(tid >> 6), lane = tid & 63, r32 = lane & 31, hi = lane >> 5;
    const int sr = tid >> 4, sc = (tid & 15) * 8, kws = KSWZ(sr, sc * 2); char* K_lds = lds + 2 * SHM_V;
    const unsigned rowoff = (unsigned)(sr * D + sc) * 2u, qoff = (unsigned)((wid * QBLK + r32) * D + hi * 8) * 2u;
#pragma unroll
    for (int d0 = 0; d0 < 8; ++d0) S.qr[d0] = load8o(cur.Q, qoff + d0 * 32);
    SLOAD_H(cur.K, 0); VMW(); SWRITE_HK(0);
    __syncthreads();
}
__device__ __forceinline__ void block(const BlockRef& cur, const BlockRef& nxt, char* lds, Seam& S, const bf16_t* __restrict__ Zg, bf16_t* __restrict__ G) {
    const int tid = threadIdx.x, wid = __builtin_amdgcn_readfirstlane(tid >> 6), lane = tid & 63, r32 = lane & 31, hi = lane >> 5;
    const int NT = (cur.P0 + QB - 1) / KVBLK + 1;
    const int qlo = cur.P0 + wid * QBLK, qm = qlo + r32 - 4 * hi;
    char* V_lds = lds; char* K_lds = lds + 2 * SHM_V;
    float* ws = (float*)(lds + OFF_WS) + wid * 64; float* li_l = ws; float* al_l = ws + 32;
    const float* nbk = (const float*)(lds + OFF_NBK);
    float m_reg = -1e30f, l_reg = 0; f32x16 o[4] = {};
    const int sr = tid >> 4, sc = (tid & 15) * 8, vst0 = v_st(sr, sc), vst1 = v_st(32 + sr, sc), kws = KSWZ(sr, sc * 2);
    const int vb0 = (int)(uintptr_t)V_lds + v_rd_base(lane);
    const bf16_t* Kh = cur.K;
    const unsigned rowoff = (unsigned)(sr * D + sc) * 2u, qoff = (unsigned)((wid * QBLK + r32) * D + hi * 8) * 2u;
#define RESC(a) do { if (__any((a) < 1.f)) { if (hi == 0) al_l[r32] = (a); asm volatile("s_waitcnt lgkmcnt(0)" ::: "memory");              \
                     _Pragma("unroll") for (int d_ = 0; d_ < 4; ++d_) _Pragma("unroll") for (int r = 0; r < 16; ++r) o[d_][r] *= al_l[crow(r, hi)]; } } while (0)
#define KBASE(t) ((t) * KVBLK)
#define MASKT(P0_, P1_, t) do { const int kb_ = KBASE(t); if (kb_ + KVBLK - 1 > qlo) mask_tile(P0_, P1_, qm - kb_); } while (0)
#define SEAM_K0() do { VMWN(8); SWRITE_HK(0); SBAR(); } while (0)
    f32x16 pA0, pA1, pB0, pB1; float mnA, mnB, alA, alB; bf16x8 pa0, pa1, pa2, pa3;
    SWRITE_HV(0); SBAR();
    if (NT > 1) SLOAD_H(Kh, KBASE(1));
    SBAR(); qkt<0>(pA0, pA1, K_lds, nbk, r32, hi, S.qr);
    MASKT(pA0, pA1, 0); partialSM(pA0, pA1, m_reg, mnA, alA);
    if (NT > 1) { VMW(); SWRITE_H(1); }
    __syncthreads();
#define HALF_STEP(PX0, PX1, mnX, alX, PY0, PY1, alY, t, KB, VB, SB) do {                                                      \
        SBAR(); qkt<KB>(PX0, PX1, K_lds, nbk + (t) * KVBLK, r32, hi, S.qr);                                                   \
        finishSM(PY0, PY1, alY, l_reg, pa0, pa1, pa2, pa3); SBAR();                                                           \
        if ((t) + 1 < NT) { SLOAD_H(Kh, KBASE((t) + 1)); SBAR(); }                                                        \
        pv_tile<VB>(o, vb0, pa0, pa1, pa2, pa3); MASKT(PX0, PX1, (t)); partialSM(PX0, PX1, m_reg, mnX, alX);                  \
        __syncthreads();                                                                                                      \
        if ((t) + 1 < NT) { VMW(); SWRITE_H(SB); }                                                                            \
        RESC(alX); __syncthreads(); } while (0)
    for (int t = 1; t + 1 < NT; t += 2) {
        HALF_STEP(pB0, pB1, mnB, alB, pA0, pA1, alA, t, 1, 0, 0);
        HALF_STEP(pA0, pA1, mnA, alA, pB0, pB1, alB, t + 1, 0, 1, 1);
    }
    SLOAD_H(nxt.K, 0); SBAR();
#pragma unroll
    for (int d0 = 0; d0 < 8; ++d0) S.qr[d0] = load8o(nxt.Q, qoff + d0 * 32);
    SBAR();
    finishSM(pA0, pA1, alA, l_reg, pa0, pa1, pa2, pa3); SBAR();
    pv_tile<0>(o, vb0, pa0, pa1, pa2, pa3);
    SBAR(); SEAM_K0();
    if (hi == 0) li_l[r32] = l_reg; asm volatile("s_waitcnt lgkmcnt(0)" ::: "memory");
    {
        float* stgA = (float*)(lds + (wid < 4 ? SHM_V + wid * 4096 : 2 * SHM_V + SHM_K + (wid - 4) * 4096));
        float* stgB = (float*)(lds + ATT_LDS + wid * 4096);
        const bf16_t* zp = Zg + (size_t)(cur.row0 + wid * QBLK) * DM + cur.h * HD + (size_t)(lane >> 4) * DM + (lane & 15) * 8;
        bf16_t* gp = G + (size_t)(cur.row0 + wid * QBLK) * DM + cur.h * HD + (size_t)(lane >> 4) * DM + (lane & 15) * 8;
        u32x4 zv[2][4];
#pragma unroll
        for (int p = 0; p < 2; ++p)
#pragma unroll
            for (int k = 0; k < 4; ++k) zv[p][k] = *(const u32x4*)(zp + (size_t)(16 * p + 4 * k) * DM);
        float rli[16];
#pragma unroll
        for (int r = 0; r < 16; ++r) rli[r] = __builtin_amdgcn_rcpf(li_l[crow(r, hi)]);
#pragma unroll
        for (int p = 0; p < 2; ++p) {
#pragma unroll
            for (int rr = 0; rr < 8; ++rr) { const int r = 8 * p + rr; float* dst = ((rr >> 2) ? stgB : stgA) + ((rr & 3) + 4 * hi) * 128 + r32;
#pragma unroll
                for (int d0 = 0; d0 < 4; ++d0) dst[d0 * 32] = o[d0][r] * rli[r]; }
            asm volatile("s_waitcnt lgkmcnt(0)" ::: "memory");
#pragma unroll
            for (int k = 0; k < 4; ++k) { const float* src = ((k >> 1) ? stgB : stgA) + (((k & 1) * 4 + (lane >> 4)) * 128 + (lane & 15) * 8);
                const f32x4 a0 = *(const f32x4*)src, a1 = *(const f32x4*)(src + 4); const u32x4 zw = zv[p][k];
                u32x4 w;
                w.x = cvt_pk_bf16(a0[0] * silu_f(bflo(zw.x)), a0[1] * silu_f(bfhi(zw.x))); w.y = cvt_pk_bf16(a0[2] * silu_f(bflo(zw.y)), a0[3] * silu_f(bfhi(zw.y)));
                w.z = cvt_pk_bf16(a1[0] * silu_f(bflo(zw.z)), a1[1] * silu_f(bfhi(zw.z))); w.w = cvt_pk_bf16(a1[2] * silu_f(bflo(zw.w)), a1[3] * silu_f(bfhi(zw.w)));
                *(u32x4*)(gp + (size_t)(16 * p + 4 * k) * DM) = w; }
            asm volatile("s_waitcnt lgkmcnt(0)" ::: "memory");
        }
    }
    __syncthreads();
#undef RESC
#undef KBASE
#undef MASKT
#undef SEAM_K0
#undef HALF_STEP
}
#undef ROWB
#undef VMWN
#undef SLOAD_H
#undef SWRITE_HK
#undef SWRITE_HV
#undef SWRITE_H

__device__ __forceinline__ void load_nbk(const float* __restrict__ lf, char* lds) {
    float* nbk = (float*)(lds + OFF_NBK); float* scr = (float*)(lds + OFF_SCAN);
    const int tid = threadIdx.x, lane = tid & 63, wid = tid >> 6, base = tid * 9;
    float v[9]; float s = 0.f;
#pragma unroll
    for (int j = 0; j < 9; ++j) { const int p = base + j; v[j] = p < LTOT ? lf[p] : 0.f; s += v[j]; }
    float incl = s;
#pragma unroll
    for (int off = 1; off < 64; off <<= 1) { const float t = __shfl_up(incl, off); if (lane >= off) incl += t; }
    if (lane == 63) scr[wid] = incl;
    __syncthreads();
    float wp = 0.f;
#pragma unroll
    for (int w = 0; w < 8; ++w) if (w < wid) wp += scr[w];
    float c = wp + incl - s;
    constexpr float INV = 1.0f / SCALE;
#pragma unroll
    for (int j = 0; j < 9; ++j) { c += v[j]; const int p = base + j; if (p < LTOT) { const int kk = p < NMETA ? p : p + 48; nbk[kk] = -c * INV; } }
    if (tid < 48) nbk[16 + tid] = -1e30f;
    __syncthreads();
}
struct Item { int bh, qb0, qb1; };
__device__ __forceinline__ Item decode(int L) { Item it; const int xcd = L & 7, k = L >> 3; it.bh = (k >> 3) * 8 + xcd; const int x = k & 7; it.qb0 = x; it.qb1 = 15 - x; return it; }
__device__ __forceinline__ BlockRef mkref(const Item& it, int pass, const bf16_t* Q, const bf16_t* K) {
    const int qb = pass ? it.qb1 : it.qb0; BlockRef r;
    r.Q = Q + ((size_t)it.bh * SEQ + (size_t)qb * QB) * D; r.K = K + (size_t)it.bh * SKV * D;
    r.P0 = 64 + qb * QB; r.row0 = (it.bh >> 4) * SEQ + qb * QB; r.h = it.bh & 15; return r;
}
__device__ __forceinline__ void attn_phase(char* lds, const bf16_t* Q, const bf16_t* K, const bf16_t* V, const bf16_t* Zg, bf16_t* G, const float* logf) {
    const int total = 512, stride = gridDim.x;
    int L = blockIdx.x; if (L >= total) return;
    Item it = decode(L); int pass = 0;
    BlockRef cur = mkref(it, 0, Q, K);
    load_nbk(logf + (size_t)it.bh * LTOT, lds);
    Seam S;
    prime(cur, lds, S);
    for (;;) {
        const bool more_pass = pass == 0, more_item = L + stride < total, last = !more_pass && !more_item;
        Item itn = it; int passn = pass + 1, Ln = L;
        if (!more_pass) { passn = 0; Ln = more_item ? L + stride : L; itn = decode(Ln); }
        const BlockRef nxt = last ? cur : mkref(itn, passn, Q, K);
        block(cur, nxt, lds, S, Zg, G);
        if (last) break;
        if (itn.bh != it.bh) load_nbk(logf + (size_t)itn.bh * LTOT, lds);
        cur = nxt; it = itn; pass = passn; L = Ln;
    }
}
#undef VMW
#undef SBAR
#undef KSWZ
}

__device__ __forceinline__ f32x4 wave_gemm16(const bf16_t* __restrict__ A, int lda, const bf16_t* __restrict__ Bt, int ldb, int K, int lane) {
    const int fr = lane & 15, fq = lane >> 4;
    const bf16_t* ap = A + (size_t)fr * lda + fq * 8; const bf16_t* bp = Bt + (size_t)fr * ldb + fq * 8;
    f32x4 acc = {0.f, 0.f, 0.f, 0.f};
#pragma unroll 8
    for (int k0 = 0; k0 < K; k0 += 32) {
        const bf16x8 a = *(const bf16x8*)(ap + k0), b = *(const bf16x8*)(bp + k0);
        acc = __builtin_amdgcn_mfma_f32_16x16x32_bf16(a, b, acc, 0, 0, 0);
    }
    return acc;
}

#define XB_TMO      128
#define XB_XCNT(j)  (256  + 64 * (j))
#define XB_XSUB(j)  (1280 + 64 * (j))
#define XB_XGEN(j)  (2304 + 64 * (j))
#define XB_TOP      3328
#define XB_TOPGEN   3392
#define XCD_BAR_WORDS 3456
#define XB_SPIN_CAP (1u << 18)
__device__ __forceinline__ unsigned xb_ld(unsigned* p)              { return __hip_atomic_load(p, __ATOMIC_RELAXED, __HIP_MEMORY_SCOPE_AGENT); }
__device__ __forceinline__ unsigned xb_add(unsigned* p, unsigned v) { return __hip_atomic_fetch_add(p, v, __ATOMIC_RELAXED, __HIP_MEMORY_SCOPE_AGENT); }
__device__ __forceinline__ unsigned xb_xcc_id() { return (unsigned)__builtin_amdgcn_s_getreg((3 << 11) | 20) & 0xFu; }
#define XB_SPIN(cond, bar) do { unsigned _sp = 0; while (cond) { __builtin_amdgcn_s_sleep(1); \
    if ((++_sp & 255u) == 0u) { if (xb_ld(&(bar)[XB_TMO])) break; if (_sp > XB_SPIN_CAP) { atomicAdd(&(bar)[XB_TMO], 1u); break; } } } } while (0)
struct XcdBarrier { unsigned* bar; unsigned x; volatile LAS unsigned* st; };
__device__ __forceinline__ XcdBarrier xcd_barrier_post(unsigned* bar, volatile LAS unsigned* st) {
    XcdBarrier b; b.bar = bar; b.x = xb_xcc_id(); b.st = st;
    if (threadIdx.x == 0) (void)xb_add(&bar[XB_XCNT(b.x)], 1u);
    return b;
}
__device__ __forceinline__ void xcd_barrier_complete(unsigned* bar, unsigned x, unsigned& nloc, unsigned& nx) {
    const unsigned G = gridDim.x * gridDim.y * gridDim.z;
    unsigned sum, cnt, mine, sp = 0u;
    for (;;) {
        sum = 0u; cnt = 0u; mine = 0u;
#pragma unroll
        for (unsigned j = 0; j < 16; ++j) { const unsigned c = xb_ld(&bar[XB_XCNT(j)]); sum += c; cnt += (c > 0u) ? 1u : 0u; mine = (j == x) ? c : mine; }
        if (sum == G) break;
        __builtin_amdgcn_s_sleep(1);
        if ((++sp & 255u) == 0u) { if (xb_ld(&bar[XB_TMO])) break; if (sp > XB_SPIN_CAP) { atomicAdd(&bar[XB_TMO], 1u); break; } }
    }
    nloc = mine > 0u ? mine : 1u; nx = cnt > 0u ? cnt : 1u;
}
__device__ __forceinline__ void xcd_barrier(const XcdBarrier& b) {
    asm volatile("s_waitcnt vmcnt(0)" ::: "memory");
    __syncthreads();
    if (threadIdx.x == 0) {
        unsigned* bar = b.bar;
        __builtin_amdgcn_s_waitcnt(0);
        unsigned nloc = b.st[0], nx = b.st[1];
        if (nloc == 0u) { xcd_barrier_complete(bar, b.x, nloc, nx); b.st[0] = nloc; b.st[1] = nx; }
        const unsigned old = xb_add(&bar[XB_XSUB(b.x)], 1u);
        const unsigned gen = old / nloc;
        if (old + 1u == (gen + 1u) * nloc) {
            __builtin_amdgcn_fence(__ATOMIC_RELEASE, "agent");
            asm volatile("s_waitcnt vmcnt(0)" ::: "memory");
            const unsigned og = xb_add(&bar[XB_TOP], 1u);
            const unsigned tg = og / nx;
            if (og + 1u == (tg + 1u) * nx) xb_add(&bar[XB_TOPGEN], 1u);
            else XB_SPIN(xb_ld(&bar[XB_TOPGEN]) == tg, bar);
            __builtin_amdgcn_fence(__ATOMIC_ACQUIRE, "agent");
            xb_add(&bar[XB_XGEN(b.x)], 1u);
            asm volatile("s_waitcnt vmcnt(0)" ::: "memory");
        } else {
            XB_SPIN(xb_ld(&bar[XB_XGEN(b.x)]) == gen, bar);
            __builtin_amdgcn_fence(__ATOMIC_ACQUIRE, "agent");
            asm volatile("s_waitcnt vmcnt(0)" ::: "memory");
        }
    }
    __syncthreads();
}

struct Args {
    const float* x; const float* meta; const float* w_in; const float* b_f; const float* w_out; const float* ln0_g; const float* ln0_b;
    const float* pw_in; const float* pw_grp; const float* p_scale; const float* pw_out; const float* ln1_g; const float* ln1_b;
    float* out; unsigned char* ws; int ph_lo, ph_hi;
};
constexpr int N_PHASES = 10;

__device__ __forceinline__ void p0_transpose_item(const float* __restrict__ W, int K, int ldw, int nblk, bf16_t* __restrict__ WT, LAS float* scr, int item, int lane) {
    const int kb = item / nblk, nb = item % nblk, k0 = 64 * kb, n0 = 32 * nb;
#pragma unroll 8
    for (int i = 0; i < 32; ++i) { const int kk = 2 * i + (lane >> 5); scr[kk * 33 + (lane & 31)] = W[(size_t)(k0 + kk) * ldw + n0 + (lane & 31)]; }
    LDS_WAIT(); asm volatile("" ::: "memory");
    const int c = lane & 7;
#pragma unroll
    for (int j = 0; j < 4; ++j) { const int n = (lane >> 3) + 8 * j; const LAS float* s = scr + (8 * c) * 33 + n;
        u32x4 o; o.x = cvt_pk_bf16(s[0 * 33], s[1 * 33]); o.y = cvt_pk_bf16(s[2 * 33], s[3 * 33]); o.z = cvt_pk_bf16(s[4 * 33], s[5 * 33]); o.w = cvt_pk_bf16(s[6 * 33], s[7 * 33]);
        *(u32x4*)(WT + (size_t)(n0 + n) * K + k0 + 8 * c) = o; }
    LDS_WAIT(); asm volatile("" ::: "memory");
}
__device__ __forceinline__ void row_to_bf16(const float* __restrict__ xrow, bf16_t* __restrict__ orow, int lane) {
    const f32x4* xr = (const f32x4*)xrow + lane; u32x2* o8 = (u32x2*)orow + lane;
    f32x4 v[8];
#pragma unroll
    for (int j = 0; j < 8; ++j) v[j] = xr[64 * j];
#pragma unroll
    for (int j = 0; j < 8; ++j) { u32x2 w; w.x = cvt_pk_bf16(v[j][0], v[j][1]); w.y = cvt_pk_bf16(v[j][2], v[j][3]); o8[64 * j] = w; }
}
__device__ __forceinline__ void ln_row(const float* __restrict__ trow, const float* __restrict__ g, const float* __restrict__ bb, bf16_t* ob, float* of, float* st, int lane) {
    const f32x4* xr = (const f32x4*)trow + lane;
    f32x4 v[8]; float s = 0.f;
#pragma unroll
    for (int j = 0; j < 8; ++j) { v[j] = xr[64 * j]; s += (v[j][0] + v[j][1]) + (v[j][2] + v[j][3]); }
    const float mean = wave_sum(s) * (1.f / DM); float s2 = 0.f;
#pragma unroll
    for (int j = 0; j < 8; ++j) { const f32x4 d = v[j] - mean; s2 += (d[0] * d[0] + d[1] * d[1]) + (d[2] * d[2] + d[3] * d[3]); }
    const float rstd = 1.0f / sqrtf(wave_sum(s2) * (1.f / DM) + LN_EPS);
    if (st && lane == 0) { st[0] = mean; st[1] = rstd; }
#pragma unroll
    for (int j = 0; j < 8; ++j) {
        const f32x4 gv = ((const f32x4*)g)[lane + 64 * j], bv = ((const f32x4*)bb)[lane + 64 * j];
        const f32x4 y = (v[j] - mean) * rstd * gv + bv;
        if (of) ((f32x4*)of)[lane + 64 * j] = y;
        if (ob) { u32x2 w; w.x = cvt_pk_bf16(y[0], y[1]); w.y = cvt_pk_bf16(y[2], y[3]); ((u32x2*)ob)[lane + 64 * j] = w; }
    }
}

__global__ void __launch_bounds__(512, 2) fwd(Args a) {
    extern __shared__ __attribute__((aligned(16))) unsigned char lds[];
    const int tid = threadIdx.x, lane = tid & 63, wid = __builtin_amdgcn_readfirstlane(tid >> 6);
    const int G = gridDim.x, bx = blockIdx.x;
    const int gw = bx * 8 + wid, NGW = G * 8;
    unsigned char* ws = a.ws;
    float* LOGF = (float*)(ws + WS_LOGF); bf16_t* MB = (bf16_t*)(ws + WS_MB); float* PM = (float*)(ws + WS_PM); bf16_t* GM = (bf16_t*)(ws + WS_GM);
    float* T0M = (float*)(ws + WS_T0M); bf16_t* H1MB = (bf16_t*)(ws + WS_H1MB); float* UM = (float*)(ws + WS_UM); float* STATS = (float*)(ws + WS_STATS);
    bf16_t* W1T = (bf16_t*)(ws + WS_W1T); bf16_t* WOT = (bf16_t*)(ws + WS_WOT); bf16_t* WPT = (bf16_t*)(ws + WS_WPT); bf16_t* WGT = (bf16_t*)(ws + WS_WGT); bf16_t* WO2T = (bf16_t*)(ws + WS_WO2T);
    bf16_t* H0B = (bf16_t*)(ws + WS_H0B); bf16_t* GB = H0B; bf16_t* EB = H0B;
    bf16_t* QB_ = (bf16_t*)(ws + WS_Q); bf16_t* H1B = QB_;
    bf16_t* KB_ = (bf16_t*)(ws + WS_K); bf16_t* UB = KB_;
    bf16_t* VB_ = (bf16_t*)(ws + WS_V); bf16_t* Z1B = VB_;
    bf16_t* ZB = (bf16_t*)(ws + WS_Z); bf16_t* DPB = ZB;
    const int lo = a.ph_lo, hi = a.ph_hi;
    volatile LAS unsigned* bst = (volatile LAS unsigned*)((LAS unsigned char*)lds + 131072);
    if (tid < 2) bst[tid] = 0u;
    __syncthreads();
    unsigned* BARW = (unsigned*)ws;
    XcdBarrier bar; bar.bar = BARW; bar.x = 0; bar.st = bst;
#ifdef ONLY_PHASE
#define IN(k) ((k) == ONLY_PHASE && lo <= (k) && (k) < hi)
#else
#define IN(k) (lo <= (k) && (k) < hi)
#endif
#define SEAM(k) do { if (IN(k) && IN((k) + 1)) { if ((k) == 0) { cg::this_grid().sync(); bar = xcd_barrier_post(BARW, bst); } else xcd_barrier(bar); } } while (0)

    if (IN(0)) {
        if (bx == 0) for (int e = tid; e < XCD_BAR_WORDS; e += 512) BARW[e] = 0u;
        LAS float* scr = (LAS float*)((LAS unsigned char*)lds + wid * 8448);
        constexpr int I1 = 32 * 256, IO = 32 * 64, IP = 32 * 128, IG1 = 8 * 16, IO2 = 32 * 64;
        constexpr int NITEMS = I1 + IO + IP + 4 * IG1 + IO2;
        for (int it = gw; it < NITEMS; it += NGW) {
            int r = it;
            if (r < I1) { p0_transpose_item(a.w_in, DM, N1F, 256, W1T, scr, r, lane); continue; } r -= I1;
            if (r < IO) { p0_transpose_item(a.w_out, DM, DM, 64, WOT, scr, r, lane); continue; } r -= IO;
            if (r < IP) { p0_transpose_item(a.pw_in, DM, 2 * DM, 128, WPT, scr, r, lane); continue; } r -= IP;
            if (r < 4 * IG1) { const int gq = r / IG1; p0_transpose_item(a.pw_grp + (size_t)gq * 512 * 512, 512, 512, 16, WGT + (size_t)gq * 512 * 512, scr, r % IG1, lane); continue; } r -= 4 * IG1;
            p0_transpose_item(a.pw_out, DM, DM, 64, WO2T, scr, r, lane);
        }
        for (int e = bx * 512 + tid; e < 16 * DM; e += G * 512) { const int k = e >> 4, n = e & 15; const float w = a.w_in[(size_t)k * N1F + N1 + n];
            W1T[(size_t)(N1 + n) * DM + k] = (bf16_t)(cvt_pk_bf16(w, 0.f) & 0xffffu); }
        for (int m = gw; m < M; m += NGW) row_to_bf16(a.x + (size_t)m * DM, H0B + (size_t)m * DM, lane);
        for (int m = gw; m < NMETA; m += NGW) row_to_bf16(a.meta + (size_t)m * DM, MB + (size_t)m * DM, lane);
        for (int e = bx * 512 + tid; e < NB * NH * 768 * 2; e += G * 512) { const int kv = e & 1, r = e >> 1, bh = r / 768, c = r % 768;
            u32x4 z = {0u, 0u, 0u, 0u}; *(u32x4*)((kv ? VB_ : KB_) + ((size_t)bh * SKV + 16) * HD + (size_t)c * 8) = z; }
    }
    SEAM(0);

    if (IN(1)) {
        const int fr = lane & 15, fq = lane >> 4;
        for (int t = gw; t < 513 + 1024; t += NGW) {
            if (t < 513) {
                const f32x4 acc = wave_gemm16(MB, DM, W1T + (size_t)t * 16 * DM, DM, DM, lane);
                const int n = t * 16 + fr;
#pragma unroll
                for (int i = 0; i < 4; ++i) {
                    const int r = 4 * fq + i; PM[(size_t)r * N1F + n] = acc[i];
                    if (n >= 2048 && n < 6144) { const int kv = n >= 4096, cc = n - (kv ? 4096 : 2048), h = cc >> 7, d = cc & 127; const bf16_t v = (bf16_t)(cvt_pk_bf16(acc[i], 0.f) & 0xffffu);
#pragma unroll
                        for (int b = 0; b < NB; ++b) (kv ? VB_ : KB_)[((size_t)(b * NH + h) * SKV + r) * HD + d] = v; }
                    if (n >= N1) { const float lf = logsig_f(acc[i] + a.b_f[fr]);
#pragma unroll
                        for (int b = 0; b < NB; ++b) LOGF[(size_t)(b * NH + fr) * LTOT + r] = lf; }
                }
            } else {
                const int t2 = t - 513;
                const f32x4 acc = wave_gemm16(H0B + (size_t)t2 * 16 * DM, DM, W1T + (size_t)N1 * DM, DM, DM, lane);
                const float bf = a.b_f[fr];
#pragma unroll
                for (int i = 0; i < 4; ++i) { const int row = t2 * 16 + 4 * fq + i, b = row >> 12, ii = row & 4095;
                    LOGF[(size_t)(b * NH + fr) * LTOT + NMETA + ii] = logsig_f(acc[i] + bf); }
            }
        }
        pg8::Gemm g{H0B, W1T, DM, DM, DM, 0}; pg8::StaticOrder S; S.init(M, N1, G, bx);
        pg8::EpiQKVZ E{QB_, KB_, VB_, ZB};
        pg8::gemm_phase<pg8::EpiQKVZ, pg8::StaticOrder, true>((LAS unsigned char*)lds, g, S, E);
    }
    SEAM(1);

    if (IN(2)) {
        for (int task = gw; task < 256; task += NGW) {
            const int h = task >> 4, i = task & 15; const float bf = a.b_f[h];
            const float q0 = PM[(size_t)i * N1F + h * HD + 2 * lane], q1 = PM[(size_t)i * N1F + h * HD + 2 * lane + 1];
            float ci = 0.f; for (int p = 0; p <= i; ++p) ci += logsig_f(PM[(size_t)p * N1F + N1 + h] + bf);
            float cj = 0.f, mx = -1e30f, l = 0.f, o0 = 0.f, o1 = 0.f;
            for (int j = 0; j <= i; ++j) {
                cj += logsig_f(PM[(size_t)j * N1F + N1 + h] + bf);
                const float k0 = PM[(size_t)j * N1F + 2048 + h * HD + 2 * lane], k1 = PM[(size_t)j * N1F + 2048 + h * HD + 2 * lane + 1];
                const float s = wave_sum(q0 * k0 + q1 * k1) * ATT_SCALE + ci - cj;
                const float mn = fmaxf(mx, s), al = __expf(mx - mn), p = __expf(s - mn);
                const float v0 = PM[(size_t)j * N1F + 4096 + h * HD + 2 * lane], v1 = PM[(size_t)j * N1F + 4096 + h * HD + 2 * lane + 1];
                l = l * al + p; o0 = o0 * al + p * v0; o1 = o1 * al + p * v1; mx = mn;
            }
            const float z0 = PM[(size_t)i * N1F + 6144 + h * HD + 2 * lane], z1 = PM[(size_t)i * N1F + 6144 + h * HD + 2 * lane + 1];
            const float rl = 1.0f / l;
            *(unsigned*)(GM + (size_t)i * DM + h * HD + 2 * lane) = cvt_pk_bf16(o0 * rl * silu_f(z0), o1 * rl * silu_f(z1));
        }
        att::attn_phase((char*)lds, QB_, KB_, VB_, ZB, GB, LOGF);
    }
    SEAM(2);

    if (IN(3)) {
        const int fr = lane & 15, fq = lane >> 4;
        for (int t = gw; t < 128; t += NGW) {
            const f32x4 acc = wave_gemm16(GM, DM, WOT + (size_t)t * 16 * DM, DM, DM, lane);
#pragma unroll
            for (int i = 0; i < 4; ++i) { const int r = 4 * fq + i, n = t * 16 + fr; T0M[(size_t)r * DM + n] = ALPHA * a.meta[(size_t)r * DM + n] + acc[i]; }
        }
        pg8::Gemm g{GB, WOT, DM, DM, DM, 0}; pg8::StaticOrder S; S.init(M, DM, G, bx);
        pg8::EpiT0 E{a.x, a.out};
        pg8::gemm_phase<pg8::EpiT0, pg8::StaticOrder, true>((LAS unsigned char*)lds, g, S, E);
    }
    SEAM(3);

    if (IN(4)) {
        for (int m = gw; m < M + NMETA; m += NGW) {
            if (m < M) ln_row(a.out + (size_t)m * DM, a.ln0_g, a.ln0_b, H1B + (size_t)m * DM, nullptr, STATS + 2 * (size_t)m, lane);
            else ln_row(T0M + (size_t)(m - M) * DM, a.ln0_g, a.ln0_b, H1MB + (size_t)(m - M) * DM, nullptr, nullptr, lane);
        }
    }
    SEAM(4);

    if (IN(5)) {
        const int fr = lane & 15, fq = lane >> 4;
        for (int t = gw; t < 128; t += NGW) {
            const f32x4 acc = wave_gemm16(H1MB, DM, WPT + (size_t)t * 16 * DM, DM, DM, lane);
#pragma unroll
            for (int i = 0; i < 4; ++i) UM[(size_t)(4 * fq + i) * DM + t * 16 + fr] = acc[i];
        }
        pg8::Gemm g{H1B, WPT, DM, DM, DM, 0}; pg8::StaticOrder S; S.init(M, 2 * DM, G, bx);
        pg8::EpiSplit2 E{UB, Z1B};
        pg8::gemm_phase<pg8::EpiSplit2, pg8::StaticOrder, true>((LAS unsigned char*)lds, g, S, E);
    }
    SEAM(5);

    if (IN(6)) {
        for (int it = bx * 512 + tid; it < (M / 32) * 256; it += G * 512) {
            const int chunk = it & 255, run = it >> 8, c0 = chunk * 8, gq = c0 >> 9, w = 2 << gq; const float invw = 1.0f / (float)w;
            const int row0 = run * 32, b = row0 >> 12, i0 = row0 & 4095;
            const bf16_t* Ub = UB + (size_t)(b * SEQ) * DM + c0; const float* Um = UM + c0;
            float sum[8];
#pragma unroll
            for (int e = 0; e < 8; ++e) sum[e] = 0.f;
            for (int j = 1; j < w; ++j) { const int i = i0 - j;
                if (i >= 0) { const u32x4 q = *(const u32x4*)(Ub + (size_t)i * DM);
                    sum[0] += bflo(q.x); sum[1] += bfhi(q.x); sum[2] += bflo(q.y); sum[3] += bfhi(q.y); sum[4] += bflo(q.z); sum[5] += bfhi(q.z); sum[6] += bflo(q.w); sum[7] += bfhi(q.w); }
                else { const f32x4 p0 = *(const f32x4*)(Um + (size_t)(16 + i) * DM), p1 = *(const f32x4*)(Um + (size_t)(16 + i) * DM + 4);
                    sum[0] += p0[0]; sum[1] += p0[1]; sum[2] += p0[2]; sum[3] += p0[3]; sum[4] += p1[0]; sum[5] += p1[1]; sum[6] += p1[2]; sum[7] += p1[3]; } }
#pragma unroll 4
            for (int s = 0; s < 32; ++s) { const int i = i0 + s;
                const u32x4 q = *(const u32x4*)(Ub + (size_t)i * DM);
                float f[8] = {bflo(q.x), bfhi(q.x), bflo(q.y), bfhi(q.y), bflo(q.z), bfhi(q.z), bflo(q.w), bfhi(q.w)};
                float d[8];
#pragma unroll
                for (int e = 0; e < 8; ++e) { sum[e] += f[e]; d[e] = sum[e] * invw - f[e]; }
                u32x4 o; o.x = cvt_pk_bf16(d[0], d[1]); o.y = cvt_pk_bf16(d[2], d[3]); o.z = cvt_pk_bf16(d[4], d[5]); o.w = cvt_pk_bf16(d[6], d[7]);
                *(u32x4*)(DPB + (size_t)(row0 + s) * DM + c0) = o;
                const int io = i - w + 1;
                if (io >= 0) { const u32x4 r = *(const u32x4*)(Ub + (size_t)io * DM);
                    sum[0] -= bflo(r.x); sum[1] -= bfhi(r.x); sum[2] -= bflo(r.y); sum[3] -= bfhi(r.y); sum[4] -= bflo(r.z); sum[5] -= bfhi(r.z); sum[6] -= bflo(r.w); sum[7] -= bfhi(r.w); }
                else { const f32x4 p0 = *(const f32x4*)(Um + (size_t)(16 + io) * DM), p1 = *(const f32x4*)(Um + (size_t)(16 + io) * DM + 4);
                    sum[0] -= p0[0]; sum[1] -= p0[1]; sum[2] -= p0[2]; sum[3] -= p0[3]; sum[4] -= p1[0]; sum[5] -= p1[1]; sum[6] -= p1[2]; sum[7] -= p1[3]; } }
        }
    }
    SEAM(6);

    if (IN(7)) {
        pg8::Gemm g{DPB, WGT, DM, 512, 512, 2}; pg8::StaticOrder S; S.init(M, DM, G, bx);
        pg8::EpiGate E{Z1B, a.p_scale, EB};
        pg8::gemm_phase<pg8::EpiGate, pg8::StaticOrder, true>((LAS unsigned char*)lds, g, S, E);
    }
    SEAM(7);

    if (IN(8)) {
        pg8::Gemm g{EB, WO2T, DM, DM, DM, 0}; pg8::StaticOrder S; S.init(M, DM, G, bx);
        pg8::EpiT1 E{a.out, STATS, a.ln0_g, a.ln0_b};
        pg8::gemm_phase<pg8::EpiT1, pg8::StaticOrder, true>((LAS unsigned char*)lds, g, S, E);
    }
    SEAM(8);

    if (IN(9)) {
        for (int m = gw; m < M; m += NGW) ln_row(a.out + (size_t)m * DM, a.ln1_g, a.ln1_b, nullptr, a.out + (size_t)m * DM, nullptr, lane);
    }
#undef IN
#undef SEAM
}

extern "C" void kernel_launch(void* const* d_in, const int* in_sizes, int n_in, void* d_out, int out_size, void* d_ws, size_t ws_size, hipStream_t stream) {
    static int grid = 0;
    if (grid == 0) {
        if (n_in != 13 || in_sizes[0] != M * DM || out_size != M * DM || ws_size < WS_END) { fprintf(stderr, "kernel_launch: shape/workspace mismatch (n_in %d, in0 %d, out %d, ws %zu)\n", n_in, n_in > 0 ? in_sizes[0] : -1, out_size, ws_size); grid = -1; return; }
        int dev = 0, cus = 0, per_cu = 0;
        (void)hipGetDevice(&dev); (void)hipDeviceGetAttribute(&cus, hipDeviceAttributeMultiprocessorCount, dev);
        if (hipFuncSetAttribute((const void*)fwd, hipFuncAttributeMaxDynamicSharedMemorySize, LDS_BYTES) != hipSuccess) { fprintf(stderr, "kernel_launch: hipFuncSetAttribute failed\n"); grid = -1; return; }
        if (hipOccupancyMaxActiveBlocksPerMultiprocessor(&per_cu, (const void*)fwd, 512, LDS_BYTES) != hipSuccess || per_cu < 1) { fprintf(stderr, "kernel_launch: occupancy query says %d\n", per_cu); per_cu = 1; }
        (void)hipGetLastError();
        grid = cus * 1;
        if (grid <= 0) grid = 256;
    }
    if (grid < 0) return;
    Args a{};
    a.x = (const float*)d_in[0]; a.meta = (const float*)d_in[1]; a.w_in = (const float*)d_in[2]; a.b_f = (const float*)d_in[3]; a.w_out = (const float*)d_in[4];
    a.ln0_g = (const float*)d_in[5]; a.ln0_b = (const float*)d_in[6]; a.pw_in = (const float*)d_in[7]; a.pw_grp = (const float*)d_in[8]; a.p_scale = (const float*)d_in[9];
    a.pw_out = (const float*)d_in[10]; a.ln1_g = (const float*)d_in[11]; a.ln1_b = (const float*)d_in[12];
    a.out = (float*)d_out; a.ws = (unsigned char*)d_ws;
#if MK_N_LAUNCHES == 1
    a.ph_lo = 0; a.ph_hi = N_PHASES;
    void* args[] = {&a};
    hipError_t e = hipLaunchCooperativeKernel((const void*)fwd, dim3(grid), dim3(512), args, LDS_BYTES, stream);
    if (e != hipSuccess) fprintf(stderr, "kernel_launch: cooperative launch failed: %s (grid %d)\n", hipGetErrorString(e), grid);
#else
    for (int p = 0; p < N_PHASES; ++p) for (int rep = 0; rep < (p == PROBE_DUP ? 2 : 1); ++rep) { a.ph_lo = p; a.ph_hi = p + 1; hipLaunchKernelGGL(fwd, dim3(grid), dim3(512), LDS_BYTES, stream, a); }
#endif
}
```

```cpp
#include <hip/hip_runtime.h>
#include <hip/hip_cooperative_groups.h>
#include <cstdio>
#include <cstdint>
namespace cg = cooperative_groups;

#ifndef MK_N_LAUNCHES
#define MK_N_LAUNCHES 1
#endif

#ifndef PROBE_DUP
#define PROBE_DUP -1
#endif
#define LAS __attribute__((address_space(3)))
typedef unsigned short bf16_t;
typedef short bf16x8 __attribute__((ext_vector_type(8)));
typedef short s16x4 __attribute__((ext_vector_type(4)));
typedef float f32x4 __attribute__((ext_vector_type(4)));
typedef float f32x2 __attribute__((ext_vector_type(2)));
typedef float f32x16 __attribute__((ext_vector_type(16)));
typedef unsigned u32x4 __attribute__((ext_vector_type(4)));
typedef unsigned u32x2 __attribute__((ext_vector_type(2)));

constexpr int DM = 2048, NB = 4, SEQ = 4096, NMETA = 16, NH = 16, HD = 128;
constexpr int M = NB * SEQ;
constexpr int LTOT = SEQ + NMETA;
constexpr int SKV = SEQ + 64;
constexpr int N1 = 8192, N1F = 8208;
constexpr float ALPHA = 1.4142135623730951f;
constexpr float LN_EPS = 1e-5f;
constexpr float ATT_SCALE = 0.08838834764831845f;

constexpr size_t MiB = 1u << 20;
constexpr size_t WS_LOGF = 1 * MiB;
constexpr size_t WS_MB = 3 * MiB;
constexpr size_t WS_PM = 3 * MiB + 256 * 1024;
constexpr size_t WS_GM = 4 * MiB;
constexpr size_t WS_T0M = 4 * MiB + 64 * 1024;
constexpr size_t WS_H1MB = 4 * MiB + 192 * 1024;
constexpr size_t WS_UM = 4 * MiB + 256 * 1024;
constexpr size_t WS_STATS = 5 * MiB;
constexpr size_t WS_W1T = 8 * MiB;
constexpr size_t WS_WOT = 41 * MiB;
constexpr size_t WS_WPT = 49 * MiB;
constexpr size_t WS_WGT = 65 * MiB;
constexpr size_t WS_WO2T = 67 * MiB;
constexpr size_t WS_H0B = 76 * MiB;
constexpr size_t WS_Q = 140 * MiB;
constexpr size_t WS_K = 204 * MiB;
constexpr size_t WS_V = 269 * MiB;
constexpr size_t WS_Z = 334 * MiB;
constexpr size_t WS_END = 398 * MiB;

constexpr int LDS_BYTES = 135168;

__device__ __forceinline__ unsigned cvt_pk_bf16(float lo, float hi) { unsigned r; asm volatile("v_cvt_pk_bf16_f32 %0, %1, %2" : "=v"(r) : "v"(lo), "v"(hi)); return r; }
__device__ __forceinline__ float bf2f(unsigned short v) { return __uint_as_float((unsigned)v << 16); }
__device__ __forceinline__ float bflo(unsigned w) { return __uint_as_float(w << 16); }
__device__ __forceinline__ float bfhi(unsigned w) { return __uint_as_float(w & 0xffff0000u); }
__device__ __forceinline__ float silu_f(float z) { return z * __builtin_amdgcn_rcpf(1.0f + __expf(-z)); }
__device__ __forceinline__ float logsig_f(float x) { return fminf(x, 0.f) - log1pf(expf(-fabsf(x))); }
__device__ __forceinline__ float wave_sum(float v) {
#pragma unroll
    for (int o = 1; o < 64; o <<= 1) v += __shfl_xor(v, o);
    return v;
}
#define LDS_WAIT() asm volatile("s_waitcnt lgkmcnt(0)" ::: "memory")

namespace pg8 {
constexpr int BM = 256, BK = 64, HALF = 128, HTB = HALF * BK * 2, STAGE_BYTES = 8 * HTB, NXCD = 8, WGM = 8;
__host__ __device__ __forceinline__ int lds_byte(int r, int c) { const int st = (r >> 4) * 2 + (c >> 5), rr = r & 15, cc = c & 31, ob = rr * 64 + cc * 2; return st * 1024 + (ob ^ (((ob >> 9) & 1) << 5)); }
__host__ __device__ __forceinline__ void stage_rc(int b, int& R, int& C) { const int st = b / 1024, sb = b % 1024, swz = sb ^ (((sb >> 9) & 1) << 5); R = (st >> 1) * 16 + swz / 64; C = (st & 1) * 32 + (swz % 64) / 2; }
__host__ __device__ __forceinline__ int perm32(int rho) { const int n = rho >> 4, i = rho & 15; return 8 * (i >> 2) + 4 * n + (i & 3); }

struct Unit { int pm, pn; };
struct Gemm { const bf16_t* A; const bf16_t* Bt; int lda, ldb, K, grp; };

struct StaticOrder {
    int nM, nN, nwg, G, c;
    __host__ __device__ void init(int M_, int N_, int G_, int c_) { nM = M_ / BM; nN = N_ / BM; nwg = nM * nN; G = G_; c = c_; }
    __host__ __device__ bool next(int i, Unit& u) const {
        const long L = (long)i * G + c; if (L >= nwg) return false;
        int wgid = (int)L; { const int q = nwg / NXCD, r = nwg % NXCD, xcd = wgid % NXCD, off = wgid / NXCD; wgid = (xcd < r ? xcd * (q + 1) : r * (q + 1) + (xcd - r) * q) + off; }
        const int nig = WGM * nN, gid = wgid / nig, fm = gid * WGM, gsz = (nM - fm) < WGM ? (nM - fm) : WGM;
        u.pm = fm + ((wgid % nig) % gsz); u.pn = (wgid % nig) / gsz; return true;
    }
};

template <class Epi, class Sched, bool ALIGN_EPI>
__device__ __forceinline__ void gemm_phase(LAS unsigned char* lds, const Gemm g, const Sched& S, const Epi& E) {
    const int tid = threadIdx.x, wid = __builtin_amdgcn_readfirstlane(tid >> 6), lane = tid & 63, wr = wid >> 2, wc = wid & 3, fr = lane & 15, fq = lane >> 4;
    const int K = g.K, nt = K / BK;
    unsigned voffA[2], voffB[2];
#pragma unroll
    for (int i = 0; i < 2; ++i) { int R, C; stage_rc(tid * 16 + i * 8192, R, C); const int Rb = Epi::PERM ? ((R & ~31) + perm32(R & 31)) : R;
        voffA[i] = (unsigned)(R * g.lda + C) * 2u; voffB[i] = (unsigned)(Rb * g.ldb + C) * 2u; }
    const size_t kstep = (size_t)(BK * 2);
    const size_t hA = (size_t)HALF * g.lda * 2, hB = (size_t)HALF * g.ldb * 2;
    const unsigned ldsw = (unsigned)wid * 1024u;
    const int aoff = lds_byte(wr * 64 + fr, fq * 8), boff = lds_byte(wc * 32 + fr, fq * 8);
#define PG8_SA(b, h) (((b) * 2 + (h)) * HTB)
#define PG8_SB(b, h) ((4 + (b) * 2 + (h)) * HTB)
#define PG8_STAGE(bufoff, gbase, voff) do { _Pragma("unroll") for (int _i = 0; _i < 2; ++_i) \
        __builtin_amdgcn_global_load_lds((const unsigned*)((const char*)(gbase) + (voff)[_i]), (LAS unsigned*)(lds + (bufoff) + ldsw + _i * 8192), 16, 0, 0); } while (0)
#define PG8_LDA(dst, b, h) do { _Pragma("unroll") for (int m = 0; m < 4; ++m) _Pragma("unroll") for (int k = 0; k < 2; ++k) dst[m][k] = *(const LAS bf16x8*)(lds + PG8_SA(b, h) + aoff + m * 2048 + k * 1024); } while (0)
#define PG8_LDB(dst, b, h) do { _Pragma("unroll") for (int n = 0; n < 2; ++n) _Pragma("unroll") for (int k = 0; k < 2; ++k) dst[n][k] = *(const LAS bf16x8*)(lds + PG8_SB(b, h) + boff + n * 2048 + k * 1024); } while (0)
#define PG8_MMA(ai, bj, At, Bt) do { __builtin_amdgcn_s_setprio(1); _Pragma("unroll") for (int m = 0; m < 4; ++m) _Pragma("unroll") for (int n = 0; n < 2; ++n) _Pragma("unroll") for (int k = 0; k < 2; ++k) \
        acc[ai][bj][m][n] = __builtin_amdgcn_mfma_f32_16x16x32_bf16(Bt[n][k], At[m][k], acc[ai][bj][m][n], 0, 0, 0); __builtin_amdgcn_s_setprio(0); } while (0)
#define PG8_WAIT_V(n) asm volatile("s_waitcnt vmcnt(" #n ")" ::: "memory")
#define PG8_WAIT_L(n) asm volatile("s_waitcnt lgkmcnt(" #n ")" ::: "memory")
#define PG8_BAR __builtin_amdgcn_s_barrier()
#define PG8_SCHED __builtin_amdgcn_sched_barrier(0)
#define PG8_UA(u) ((const char*)g.A + (size_t)(u).pm * 2 * hA + (g.grp ? (size_t)((u).pn / g.grp) * (size_t)K * 2 : (size_t)0))
#define PG8_UB(u) ((const char*)g.Bt + (size_t)(u).pn * 2 * hB)
    Unit cur, nxt; int ui = 0;
    if (!S.next(0, cur)) return;
    f32x4 acc[2][2][4][2];
#pragma unroll
    for (int a = 0; a < 2; ++a)
#pragma unroll
        for (int b = 0; b < 2; ++b)
#pragma unroll
            for (int m = 0; m < 4; ++m)
#pragma unroll
                for (int n = 0; n < 2; ++n) acc[a][b][m][n] = (f32x4){0.f, 0.f, 0.f, 0.f};
    bf16x8 At[4][2], B0[2][2], B1[2][2];
    const char* cA = PG8_UA(cur); const char* cB = PG8_UB(cur);
    PG8_STAGE(PG8_SB(0, 0), cB, voffB); PG8_STAGE(PG8_SB(0, 1), cB + hB, voffB); PG8_STAGE(PG8_SA(0, 0), cA, voffA); PG8_STAGE(PG8_SA(0, 1), cA + hA, voffA);
    if (wr == 1) PG8_BAR;
    PG8_WAIT_V(2); PG8_BAR;
    PG8_STAGE(PG8_SB(1, 0), cB + kstep, voffB); PG8_STAGE(PG8_SA(1, 0), cA + kstep, voffA); PG8_STAGE(PG8_SB(1, 1), cB + hB + kstep, voffB);
    PG8_WAIT_V(6); PG8_BAR;
    for (;;) {
        const bool has_next = S.next(ui + 1, nxt);
        const char* nA = has_next ? PG8_UA(nxt) : cA; const char* nB = has_next ? PG8_UB(nxt) : cB;
        for (int t = 0; t < nt; t += 2) {
            const bool last = (t == nt - 2);
            const char* a1 = cA + (size_t)(t + 1) * kstep;
            const char* a2 = last ? nA : cA + (size_t)(t + 2) * kstep; const char* b2 = last ? nB : cB + (size_t)(t + 2) * kstep;
            const char* a3 = a2 + kstep; const char* b3 = b2 + kstep;
            PG8_LDB(B0, 0, 0); PG8_LDB(B1, 0, 1); PG8_SCHED; PG8_LDA(At, 0, 0); PG8_STAGE(PG8_SA(1, 1), a1 + hA, voffA);
            PG8_WAIT_V(8); PG8_WAIT_L(0); PG8_BAR; PG8_MMA(0, 0, At, B0); PG8_MMA(0, 1, At, B1); PG8_BAR; PG8_SCHED;
            PG8_LDA(At, 0, 1); PG8_STAGE(PG8_SB(0, 0), b2, voffB); PG8_STAGE(PG8_SB(0, 1), b2 + hB, voffB); PG8_STAGE(PG8_SA(0, 0), a2, voffA);
            PG8_WAIT_V(8); PG8_WAIT_L(0); PG8_BAR; PG8_MMA(1, 0, At, B0); PG8_MMA(1, 1, At, B1); PG8_BAR; PG8_SCHED;
            PG8_LDB(B0, 1, 0); PG8_LDB(B1, 1, 1); PG8_SCHED; PG8_LDA(At, 1, 0); PG8_STAGE(PG8_SA(0, 1), a2 + hA, voffA);
            PG8_WAIT_V(8); PG8_WAIT_L(0); PG8_BAR; PG8_MMA(0, 0, At, B0); PG8_MMA(0, 1, At, B1); PG8_BAR; PG8_SCHED;
            PG8_LDA(At, 1, 1); PG8_STAGE(PG8_SB(1, 0), b3, voffB); PG8_STAGE(PG8_SB(1, 1), b3 + hB, voffB); PG8_STAGE(PG8_SA(1, 0), a3, voffA);
            PG8_WAIT_V(8); PG8_WAIT_L(0); PG8_BAR; PG8_MMA(1, 0, At, B0); PG8_MMA(1, 1, At, B1); PG8_BAR; PG8_SCHED;
        }
        if constexpr (ALIGN_EPI) { if (wr == 0) PG8_BAR; }
        E(acc, cur, wr, wc, fr, fq);
        if (!has_next) break;
#pragma unroll
        for (int a = 0; a < 2; ++a)
#pragma unroll
            for (int b = 0; b < 2; ++b)
#pragma unroll
                for (int m = 0; m < 4; ++m)
#pragma unroll
                    for (int n = 0; n < 2; ++n) acc[a][b][m][n] = (f32x4){0.f, 0.f, 0.f, 0.f};
        cur = nxt; cA = nA; cB = nB; ++ui;
        if constexpr (ALIGN_EPI) { if (wr == 1) PG8_BAR; }
    }
    PG8_WAIT_V(0);
    if constexpr (!ALIGN_EPI) { if (wr == 0) PG8_BAR; }
    PG8_BAR;
#undef PG8_SA
#undef PG8_SB
#undef PG8_STAGE
#undef PG8_LDA
#undef PG8_LDB
#undef PG8_MMA
#undef PG8_WAIT_V
#undef PG8_WAIT_L
#undef PG8_BAR
#undef PG8_SCHED
#undef PG8_UA
#undef PG8_UB
}

__device__ __forceinline__ u32x4 pack8f(f32x4 a, f32x4 b) { u32x4 w; w.x = cvt_pk_bf16(a[0], a[1]); w.y = cvt_pk_bf16(a[2], a[3]); w.z = cvt_pk_bf16(b[0], b[1]); w.w = cvt_pk_bf16(b[2], b[3]); return w; }

struct EpiQKVZ {
    static constexpr bool PERM = true;
    bf16_t *Q, *Kb, *Vb, *Z;
    __device__ __forceinline__ void operator()(const f32x4 (&acc)[2][2][4][2], const Unit& u, int wr, int wc, int fr, int fq) const {
        const int t = u.pn >> 3, hbase = (u.pn & 7) * 2, d = wc * 32 + 8 * fq;
#pragma unroll
        for (int ai = 0; ai < 2; ++ai)
#pragma unroll
            for (int m = 0; m < 4; ++m) {
                const int row = u.pm * BM + ai * HALF + wr * 64 + m * 16 + fr, b = row >> 12, i = row & 4095;
#pragma unroll
                for (int bj = 0; bj < 2; ++bj) {
                    const int h = hbase + bj; bf16_t* p;
                    if (t == 0) p = Q + ((size_t)((b * NH + h) * SEQ + i)) * HD + d;
                    else if (t == 3) p = Z + (size_t)row * DM + h * HD + d;
                    else p = (t == 1 ? Kb : Vb) + ((size_t)((b * NH + h) * SKV + 64 + i)) * HD + d;
                    *(u32x4*)p = pack8f(acc[ai][bj][m][0], acc[ai][bj][m][1]);
                }
            }
    }
};
struct EpiSplit2 {
    static constexpr bool PERM = true;
    bf16_t *O0, *O1;
    __device__ __forceinline__ void operator()(const f32x4 (&acc)[2][2][4][2], const Unit& u, int wr, int wc, int fr, int fq) const {
        bf16_t* base = (u.pn < 8 ? O0 : O1) + (u.pn & 7) * BM + wc * 32 + 8 * fq;
#pragma unroll
        for (int ai = 0; ai < 2; ++ai)
#pragma unroll
            for (int m = 0; m < 4; ++m) {
                const int row = u.pm * BM + ai * HALF + wr * 64 + m * 16 + fr;
#pragma unroll
                for (int bj = 0; bj < 2; ++bj) *(u32x4*)(base + (size_t)row * DM + bj * HALF) = pack8f(acc[ai][bj][m][0], acc[ai][bj][m][1]);
            }
    }
};
struct EpiT0 {
    static constexpr bool PERM = false;
    const float* X; float* O;
    __device__ __forceinline__ void operator()(const f32x4 (&acc)[2][2][4][2], const Unit& u, int wr, int wc, int fr, int fq) const {
        const int col0 = u.pn * BM + wc * 32 + 4 * fq;
#pragma unroll
        for (int ai = 0; ai < 2; ++ai)
#pragma unroll
            for (int m = 0; m < 4; ++m) {
                const size_t off = (size_t)(u.pm * BM + ai * HALF + wr * 64 + m * 16 + fr) * DM + col0;
#pragma unroll
                for (int bj = 0; bj < 2; ++bj)
#pragma unroll
                    for (int n = 0; n < 2; ++n) { const f32x4 xv = *(const f32x4*)(X + off + bj * HALF + n * 16); *(f32x4*)(O + off + bj * HALF + n * 16) = xv * ALPHA + acc[ai][bj][m][n]; }
            }
    }
};
struct EpiGate {
    static constexpr bool PERM = true;
    const bf16_t* Z1; const float* scale; bf16_t* O;
    __device__ __forceinline__ void operator()(const f32x4 (&acc)[2][2][4][2], const Unit& u, int wr, int wc, int fr, int fq) const {
        const int col0 = u.pn * BM + wc * 32 + 8 * fq;
        f32x4 sv[2][2];
#pragma unroll
        for (int bj = 0; bj < 2; ++bj) { sv[bj][0] = *(const f32x4*)(scale + col0 + bj * HALF); sv[bj][1] = *(const f32x4*)(scale + col0 + bj * HALF + 4); }
#pragma unroll
        for (int ai = 0; ai < 2; ++ai)
#pragma unroll
            for (int m = 0; m < 4; ++m) {
                const size_t off = (size_t)(u.pm * BM + ai * HALF + wr * 64 + m * 16 + fr) * DM + col0;
#pragma unroll
                for (int bj = 0; bj < 2; ++bj) {
                    const u32x4 zw = *(const u32x4*)(Z1 + off + bj * HALF);
                    f32x4 v0 = acc[ai][bj][m][0] * sv[bj][0], v1 = acc[ai][bj][m][1] * sv[bj][1];
                    v0[0] *= silu_f(bflo(zw.x)); v0[1] *= silu_f(bfhi(zw.x)); v0[2] *= silu_f(bflo(zw.y)); v0[3] *= silu_f(bfhi(zw.y));
                    v1[0] *= silu_f(bflo(zw.z)); v1[1] *= silu_f(bfhi(zw.z)); v1[2] *= silu_f(bflo(zw.w)); v1[3] *= silu_f(bfhi(zw.w));
                    *(u32x4*)(O + off + bj * HALF) = pack8f(v0, v1);
                }
            }
    }
};
struct EpiT1 {
    static constexpr bool PERM = false;
    float* T; const float* stats; const float* g; const float* bb;
    __device__ __forceinline__ void operator()(const f32x4 (&acc)[2][2][4][2], const Unit& u, int wr, int wc, int fr, int fq) const {
        const int col0 = u.pn * BM + wc * 32 + 4 * fq;
        f32x4 gv[2][2], bv[2][2];
#pragma unroll
        for (int bj = 0; bj < 2; ++bj)
#pragma unroll
            for (int n = 0; n < 2; ++n) { gv[bj][n] = *(const f32x4*)(g + col0 + bj * HALF + n * 16); bv[bj][n] = *(const f32x4*)(bb + col0 + bj * HALF + n * 16); }
#pragma unroll
        for (int ai = 0; ai < 2; ++ai)
#pragma unroll
            for (int m = 0; m < 4; ++m) {
                const int row = u.pm * BM + ai * HALF + wr * 64 + m * 16 + fr;
                const f32x2 st = *(const f32x2*)(stats + 2 * (size_t)row);
                const size_t off = (size_t)row * DM + col0;
#pragma unroll
                for (int bj = 0; bj < 2; ++bj)
#pragma unroll
                    for (int n = 0; n < 2; ++n) { const f32x4 tv = *(const f32x4*)(T + off + bj * HALF + n * 16);
                        const f32x4 h1 = (tv - st.x) * st.y * gv[bj][n] + bv[bj][n];
                        *(f32x4*)(T + off + bj * HALF + n * 16) = h1 * ALPHA + acc[ai][bj][m][n]; }
            }
    }
};
}

namespace att {
constexpr int D = 128, NW = 8, QBLK = 32, KVBLK = 64, QB = 256;
constexpr int SHM_V = KVBLK * D * 2, SHM_K = KVBLK * D * 2;
constexpr int OFF_WS = 2 * SHM_V + 2 * SHM_K;
constexpr int OFF_NBK = OFF_WS + NW * 64 * 4;
constexpr int OFF_SCAN = OFF_NBK + SKV * 4;
constexpr int ATT_LDS = OFF_SCAN + 64;
constexpr float SCALE = ATT_SCALE;
constexpr float THR = 8.f;
#define KSWZ(row, colB) ((row) * 256 + ((colB) ^ (((row) & 7) << 4)))
#define SBAR() __builtin_amdgcn_sched_barrier(0)
__device__ __forceinline__ int v_st(int k, int c) { const int kk = (k & ~0xC) | ((k & 4) << 1) | ((k & 8) >> 1); return ((kk >> 3) * 4 + (c >> 5)) * 512 + ((kk & 7) * 32 + (c & 31)) * 2; }
__device__ __forceinline__ int v_rd_base(int lane) { return ((lane & 3) << 3) | (((lane >> 2) & 3) << 6) | (((lane >> 4) & 1) << 5) | (((lane >> 5) & 1) << 8); }
constexpr int v_rd_off(int d0, int ks, int half) { return d0 * 512 + ks * 4096 + half * 2048; }
__device__ __forceinline__ int crow(int r, int hi) { return (r & 3) + 8 * (r >> 2) + 4 * hi; }
__device__ __forceinline__ bf16x8 load8(const bf16_t* p) { return *reinterpret_cast<const bf16x8*>(p); }
__device__ __forceinline__ void mask_tile(f32x16& p0, f32x16& p1, int dq) {
    const float NEG = -__builtin_inff();
#pragma unroll
    for (int r = 0; r < 16; ++r) {
        const int c = (r & 3) + 8 * (r >> 2);
        if (dq - c < 0) p0[r] = NEG;
        if (dq - c - 32 < 0) p1[r] = NEG;
    }
}
__device__ __forceinline__ void partialSM(f32x16& p0, f32x16& p1, float& m_reg, float& mn, float& alpha) {
    float pmax = p0[0];
#pragma unroll
    for (int r = 1; r < 16; ++r) pmax = fmaxf(pmax, p0[r]);
#pragma unroll
    for (int r = 0; r < 16; ++r) pmax = fmaxf(pmax, p1[r]);
    { auto rr = __builtin_amdgcn_permlane32_swap(__float_as_uint(pmax), __float_as_uint(pmax), false, false);
      pmax = fmaxf(__uint_as_float(rr[0]), __uint_as_float(rr[1])); }
    constexpr float C2 = 1.4426950408889634f * SCALE;
    if (__builtin_expect(__all((pmax - m_reg) * SCALE <= THR), 1)) { mn = m_reg; alpha = 1.f; }
    else { mn = fmaxf(m_reg, pmax); alpha = __builtin_amdgcn_exp2f((m_reg - mn) * C2); m_reg = mn; }
    const float mnL = -mn * C2;
#pragma unroll
    for (int r = 0; r < 16; ++r) p0[r] = fmaf(p0[r], C2, mnL);
#pragma unroll
    for (int r = 0; r < 16; ++r) p1[r] = fmaf(p1[r], C2, mnL);
#pragma unroll
    for (int r = 0; r < 16; ++r) p0[r] = __builtin_amdgcn_exp2f(p0[r]);
}
__device__ __forceinline__ void finishSM(f32x16& p0, f32x16& p1, float alpha, float& l_reg, bf16x8& pa0, bf16x8& pa1, bf16x8& pa2, bf16x8& pa3) {
#pragma unroll
    for (int r = 0; r < 16; ++r) p1[r] = __builtin_amdgcn_exp2f(p1[r]);
    float ps = 0;
#pragma unroll
    for (int r = 0; r < 16; ++r) ps += p0[r];
#pragma unroll
    for (int r = 0; r < 16; ++r) ps += p1[r];
    { auto rr = __builtin_amdgcn_permlane32_swap(__float_as_uint(ps), __float_as_uint(ps), false, false);
      ps = __uint_as_float(rr[0]) + __uint_as_float(rr[1]); }
    l_reg = l_reg * alpha + ps;
#define PK4(P, B_, OUT) do { unsigned a0 = cvt_pk_bf16(P[B_+0], P[B_+1]), a1 = cvt_pk_bf16(P[B_+2], P[B_+3]);                          \
        unsigned b0 = cvt_pk_bf16(P[B_+4], P[B_+5]), b1 = cvt_pk_bf16(P[B_+6], P[B_+7]);                                             \
        auto r0 = __builtin_amdgcn_permlane32_swap(a0, b0, false, false); auto r1 = __builtin_amdgcn_permlane32_swap(a1, b1, false, false); \
        u32x4 w = {r0[0], r1[0], r0[1], r1[1]}; OUT = *reinterpret_cast<bf16x8*>(&w); } while (0)
    PK4(p0, 0, pa0); PK4(p0, 8, pa1); PK4(p1, 0, pa2); PK4(p1, 8, pa3);
#undef PK4
}
template <int KB>
__device__ __forceinline__ void qkt(f32x16& p0, f32x16& p1, const char* K_lds, const float* nbk_t, int r32, int hi, const bf16x8* qr) {
    const f32x4* bp = (const f32x4*)(nbk_t + 4 * hi);
#pragma unroll
    for (int g = 0; g < 4; ++g) { const f32x4 a = bp[2 * g], b = bp[8 + 2 * g];
        p0[4 * g] = a[0]; p0[4 * g + 1] = a[1]; p0[4 * g + 2] = a[2]; p0[4 * g + 3] = a[3];
        p1[4 * g] = b[0]; p1[4 * g + 1] = b[1]; p1[4 * g + 2] = b[2]; p1[4 * g + 3] = b[3]; }
    const char* kb[4];
#pragma unroll
    for (int dd = 0; dd < 4; ++dd) kb[dd] = K_lds + KB * SHM_K + KSWZ(r32, (dd * 16 + hi * 8) * 2);
#pragma unroll
    for (int d0 = 0; d0 < 8; ++d0) { const char* a = kb[d0 & 3] + (d0 >> 2) * 128;
        bf16x8 b0 = *reinterpret_cast<const bf16x8*>(a);
        bf16x8 b1 = *reinterpret_cast<const bf16x8*>(a + 32 * 256);
        p0 = __builtin_amdgcn_mfma_f32_32x32x16_bf16(b0, qr[d0], p0, 0, 0, 0);
        p1 = __builtin_amdgcn_mfma_f32_32x32x16_bf16(b1, qr[d0], p1, 0, 0, 0); }
}
template <int VB>
__device__ __forceinline__ void pv_tile(f32x16* o, int vb0, bf16x8 pa0, bf16x8 pa1, bf16x8 pa2, bf16x8 pa3) {
#define TRRD(dst, off) asm volatile("ds_read_b64_tr_b16 %0, %1 offset:%2" : "=&v"(dst) : "v"(vb0), "i"(off) : "memory")
#define PV_D0(d0) do { s16x4 l0, l1, l2, l3, h0, h1, h2, h3; constexpr int b_ = VB * SHM_V + v_rd_off(d0, 0, 0); \
        TRRD(l0, b_); TRRD(h0, b_ + 2048); TRRD(l1, b_ + 4096); TRRD(h1, b_ + 6144); TRRD(l2, b_ + 8192); TRRD(h2, b_ + 10240); TRRD(l3, b_ + 12288); TRRD(h3, b_ + 14336); \
        asm volatile("s_waitcnt lgkmcnt(0)" ::: "memory"); SBAR();   \
        o[d0] = __builtin_amdgcn_mfma_f32_32x32x16_bf16(pa0, (bf16x8){l0[0], l0[1], l0[2], l0[3], h0[0], h0[1], h0[2], h0[3]}, o[d0], 0, 0, 0);   \
        o[d0] = __builtin_amdgcn_mfma_f32_32x32x16_bf16(pa1, (bf16x8){l1[0], l1[1], l1[2], l1[3], h1[0], h1[1], h1[2], h1[3]}, o[d0], 0, 0, 0);   \
        o[d0] = __builtin_amdgcn_mfma_f32_32x32x16_bf16(pa2, (bf16x8){l2[0], l2[1], l2[2], l2[3], h2[0], h2[1], h2[2], h2[3]}, o[d0], 0, 0, 0);   \
        o[d0] = __builtin_amdgcn_mfma_f32_32x32x16_bf16(pa3, (bf16x8){l3[0], l3[1], l3[2], l3[3], h3[0], h3[1], h3[2], h3[3]}, o[d0], 0, 0, 0); } while (0)
    PV_D0(0); PV_D0(1); PV_D0(2); PV_D0(3);
#undef PV_D0
#undef TRRD
}

struct BlockRef { const bf16_t* Q; const bf16_t* K; int P0; int row0; int h; };
struct Seam { bf16x8 qr[8]; bf16x8 st_v0, st_v1, st_k0, st_k1; };
constexpr size_t VDELTA = (WS_V - WS_K) / 2;
__device__ __forceinline__ bf16x8 load8o(const bf16_t* base, unsigned byteoff) { return *reinterpret_cast<const bf16x8*>((const char*)base + byteoff); }
#define ROWB(k0, rr) (rowoff + (unsigned)(((k0) + (rr)) * D * 2))
#define VMW() asm volatile("s_waitcnt vmcnt(0)" ::: "memory")
#define VMWN(n) asm volatile("s_waitcnt vmcnt(%0)" :: "i"(n) : "memory")
#define SLOAD_H(Kp, k0) do { S.st_v0 = load8o((Kp) + VDELTA, ROWB(k0, 0)); S.st_v1 = load8o((Kp) + VDELTA, ROWB(k0, 32));              \
                         S.st_k0 = load8o(Kp, ROWB(k0, 0)); S.st_k1 = load8o(Kp, ROWB(k0, 32)); } while (0)
#define SWRITE_HK(bf) do { *(bf16x8*)(K_lds + (bf) * SHM_K + kws) = S.st_k0; *(bf16x8*)(K_lds + (bf) * SHM_K + kws + 32 * 256) = S.st_k1; } while (0)
#define SWRITE_HV(bf) do { *(bf16x8*)(V_lds + (bf) * SHM_V + vst0) = S.st_v0; *(bf16x8*)(V_lds + (bf) * SHM_V + vst1) = S.st_v1; } while (0)
#define SWRITE_H(bf) do { SWRITE_HV(bf); SWRITE_HK(bf); } while (0)
__device__ __forceinline__ void prime(const BlockRef& cur, char* lds, Seam& S) {
    const int tid = threadIdx.x, wid = __builtin_amdgcn_readfirstlane(tid >> 6), lane = tid & 63, r32 = lane & 31, hi = lane >> 5;
    const int sr = tid >> 4, sc = (tid & 15) * 8, kws = KSWZ(sr, sc * 2); char* K_lds = lds + 2 * SHM_V;
    const unsigned rowoff = (unsigned)(sr * D + sc) * 2u, qoff = (unsigned)((wid * QBLK + r32) * D + hi * 8) * 2u;
#pragma unroll
    for (int d0 = 0; d0 < 8; ++d0) S.qr[d0] = load8o(cur.Q, qoff + d0 * 32);
    SLOAD_H(cur.K, 0); VMW(); SWRITE_HK(0);
    __syncthreads();
}
__device__ __forceinline__ void block(const BlockRef& cur, const BlockRef& nxt, char* lds, Seam& S, const bf16_t* __restrict__ Zg, bf16_t* __restrict__ G) {
    const int tid = threadIdx.x, wid = __builtin_amdgcn_readfirstlane(tid >> 6), lane = tid & 63, r32 = lane & 31, hi = lane >> 5;
    const int NT = (cur.P0 + QB - 1) / KVBLK + 1;
    const int qlo = cur.P0 + wid * QBLK, qm = qlo + r32 - 4 * hi;
    char* V_lds = lds; char* K_lds = lds + 2 * SHM_V;
    float* ws = (float*)(lds + OFF_WS) + wid * 64; float* li_l = ws; float* al_l = ws + 32;
    const float* nbk = (const float*)(lds + OFF_NBK);
    float m_reg = -1e30f, l_reg = 0; f32x16 o[4] = {};
    const int sr = tid >> 4, sc = (tid & 15) * 8, vst0 = v_st(sr, sc), vst1 = v_st(32 + sr, sc), kws = KSWZ(sr, sc * 2);
    const int vb0 = (int)(uintptr_t)V_lds + v_rd_base(lane);
    const bf16_t* Kh = cur.K;
    const unsigned rowoff = (unsigned)(sr * D + sc) * 2u, qoff = (unsigned)((wid * QBLK + r32) * D + hi * 8) * 2u;
#define RESC(a) do { if (__any((a) < 1.f)) { if (hi == 0) al_l[r32] = (a); asm volatile("s_waitcnt lgkmcnt(0)" ::: "memory");              \
                     _Pragma("unroll") for (int d_ = 0; d_ < 4; ++d_) _Pragma("unroll") for (int r = 0; r < 16; ++r) o[d_][r] *= al_l[crow(r, hi)]; } } while (0)
#define KBASE(t) ((t) * KVBLK)
#define MASKT(P0_, P1_, t) do { const int kb_ = KBASE(t); if (kb_ + KVBLK - 1 > qlo) mask_tile(P0_, P1_, qm - kb_); } while (0)
#define SEAM_K0() do { VMWN(8); SWRITE_HK(0); SBAR(); } while (0)
    f32x16 pA0, pA1, pB0, pB1; float mnA, mnB, alA, alB; bf16x8 pa0, pa1, pa2, pa3;
    SWRITE_HV(0); SBAR();
    if (NT > 1) SLOAD_H(Kh, KBASE(1));
    u32x4 kd[8];
    { const unsigned koff = (unsigned)((cur.P0 + wid * QBLK + r32) * D + hi * 8) * 2u;
#pragma unroll
      for (int d0 = 0; d0 < 8; ++d0) kd[d0] = *reinterpret_cast<const u32x4*>((const char*)Kh + koff + d0 * 32); }
    SBAR(); qkt<0>(pA0, pA1, K_lds, nbk, r32, hi, S.qr);
    { float ds = 0.f;
#pragma unroll
      for (int d0 = 0; d0 < 8; ++d0) { const u32x4 qq = *reinterpret_cast<const u32x4*>(&S.qr[d0]); const u32x4 kk = kd[d0];
          ds += bflo(qq.x) * bflo(kk.x) + bfhi(qq.x) * bfhi(kk.x) + bflo(qq.y) * bflo(kk.y) + bfhi(qq.y) * bfhi(kk.y)
              + bflo(qq.z) * bflo(kk.z) + bfhi(qq.z) * bfhi(kk.z) + bflo(qq.w) * bflo(kk.w) + bfhi(qq.w) * bfhi(kk.w); }
      auto rr = __builtin_amdgcn_permlane32_swap(__float_as_uint(ds), __float_as_uint(ds), false, false);
      m_reg = __uint_as_float(rr[0]) + __uint_as_float(rr[1]) + nbk[cur.P0 + wid * QBLK + r32]; }
    MASKT(pA0, pA1, 0); partialSM(pA0, pA1, m_reg, mnA, alA);
    if (NT > 1) { VMW(); SWRITE_H(1); }
    __syncthreads();
#define HALF_STEP(PX0, PX1, mnX, alX, PY0, PY1, alY, t, KB, VB, SB) do {                                                      \
        SBAR(); qkt<KB>(PX0, PX1, K_lds, nbk + (t) * KVBLK, r32, hi, S.qr);                                                   \
        finishSM(PY0, PY1, alY, l_reg, pa0, pa1, pa2, pa3); SBAR();                                                           \
        if ((t) + 1 < NT) { SLOAD_H(Kh, KBASE((t) + 1)); SBAR(); }                                                        \
        pv_tile<VB>(o, vb0, pa0, pa1, pa2, pa3); MASKT(PX0, PX1, (t)); partialSM(PX0, PX1, m_reg, mnX, alX);                  \
        __syncthreads();                                                                                                      \
        if ((t) + 1 < NT) { VMW(); SWRITE_H(SB); }                                                                            \
        RESC(alX); __syncthreads(); } while (0)
    for (int t = 1; t + 1 < NT; t += 2) {
        HALF_STEP(pB0, pB1, mnB, alB, pA0, pA1, alA, t, 1, 0, 0);
        HALF_STEP(pA0, pA1, mnA, alA, pB0, pB1, alB, t + 1, 0, 1, 1);
    }
    SLOAD_H(nxt.K, 0); SBAR();
#pragma unroll
    for (int d0 = 0; d0 < 8; ++d0) S.qr[d0] = load8o(nxt.Q, qoff + d0 * 32);
    SBAR();
    finishSM(pA0, pA1, alA, l_reg, pa0, pa1, pa2, pa3); SBAR();
    pv_tile<0>(o, vb0, pa0, pa1, pa2, pa3);
    SBAR(); SEAM_K0();
    if (hi == 0) li_l[r32] = l_reg; asm volatile("s_waitcnt lgkmcnt(0)" ::: "memory");
    {
        float* stgA = (float*)(lds + (wid < 4 ? SHM_V + wid * 4096 : 2 * SHM_V + SHM_K + (wid - 4) * 4096));
        float* stgB = (float*)(lds + ATT_LDS + wid * 4096);
        const bf16_t* zp = Zg + (size_t)(cur.row0 + wid * QBLK) * DM + cur.h * HD + (size_t)(lane >> 4) * DM + (lane & 15) * 8;
        bf16_t* gp = G + (size_t)(cur.row0 + wid * QBLK) * DM + cur.h * HD + (size_t)(lane >> 4) * DM + (lane & 15) * 8;
        u32x4 zv[2][4];
#pragma unroll
        for (int p = 0; p < 2; ++p)
#pragma unroll
            for (int k = 0; k < 4; ++k) zv[p][k] = *(const u32x4*)(zp + (size_t)(16 * p + 4 * k) * DM);
        float rli[16];
#pragma unroll
        for (int r = 0; r < 16; ++r) rli[r] = __builtin_amdgcn_rcpf(li_l[crow(r, hi)]);
#pragma unroll
        for (int p = 0; p < 2; ++p) {
#pragma unroll
            for (int rr = 0; rr < 8; ++rr) { const int r = 8 * p + rr; float* dst = ((rr >> 2) ? stgB : stgA) + ((rr & 3) + 4 * hi) * 128 + r32;
#pragma unroll
                for (int d0 = 0; d0 < 4; ++d0) dst[d0 * 32] = o[d0][r] * rli[r]; }
            asm volatile("s_waitcnt lgkmcnt(0)" ::: "memory");
#pragma unroll
            for (int k = 0; k < 4; ++k) { const float* src = ((k >> 1) ? stgB : stgA) + (((k & 1) * 4 + (lane >> 4)) * 128 + (lane & 15) * 8);
                const f32x4 a0 = *(const f32x4*)src, a1 = *(const f32x4*)(src + 4); const u32x4 zw = zv[p][k];
                u32x4 w;
                w.x = cvt_pk_bf16(a0[0] * silu_f(bflo(zw.x)), a0[1] * silu_f(bfhi(zw.x))); w.y = cvt_pk_bf16(a0[2] * silu_f(bflo(zw.y)), a0[3] * silu_f(bfhi(zw.y)));
                w.z = cvt_pk_bf16(a1[0] * silu_f(bflo(zw.z)), a1[1] * silu_f(bfhi(zw.z))); w.w = cvt_pk_bf16(a1[2] * silu_f(bflo(zw.w)), a1[3] * silu_f(bfhi(zw.w)));
                *(u32x4*)(gp + (size_t)(16 * p + 4 * k) * DM) = w; }
            asm volatile("s_waitcnt lgkmcnt(0)" ::: "memory");
        }
    }
    __syncthreads();
#undef RESC
#undef KBASE
#undef MASKT
#undef SEAM_K0
#undef HALF_STEP
}
#undef ROWB
#undef VMWN
#undef SLOAD_H
#undef SWRITE_HK
#undef SWRITE_HV
#undef SWRITE_H

__device__ __forceinline__ void load_nbk(const float* __restrict__ lf, char* lds) {
    float* nbk = (float*)(lds + OFF_NBK); float* scr = (float*)(lds + OFF_SCAN);
    const int tid = threadIdx.x, lane = tid & 63, wid = tid >> 6, base = tid * 9;
    float v[9]; float s = 0.f;
#pragma unroll
    for (int j = 0; j < 9; ++j) { const int p = base + j; v[j] = p < LTOT ? lf[p] : 0.f; s += v[j]; }
    float incl = s;
#pragma unroll
    for (int off = 1; off < 64; off <<= 1) { const float t = __shfl_up(incl, off); if (lane >= off) incl += t; }
    if (lane == 63) scr[wid] = incl;
    __syncthreads();
    float wp = 0.f;
#pragma unroll
    for (int w = 0; w < 8; ++w) if (w < wid) wp += scr[w];
    float c = wp + incl - s;
    constexpr float INV = 1.0f / SCALE;
#pragma unroll
    for (int j = 0; j < 9; ++j) { c += v[j]; const int p = base + j; if (p < LTOT) { const int kk = p < NMETA ? p : p + 48; nbk[kk] = -c * INV; } }
    if (tid < 48) nbk[16 + tid] = -1e30f;
    __syncthreads();
}
struct Item { int bh, qb0, qb1; };
__device__ __forceinline__ Item decode(int L) { Item it; const int xcd = L & 7, k = L >> 3; it.bh = (k >> 3) * 8 + xcd; const int x = k & 7; it.qb0 = x; it.qb1 = 15 - x; return it; }
__device__ __forceinline__ BlockRef mkref(const Item& it, int pass, const bf16_t* Q, const bf16_t* K) {
    const int qb = pass ? it.qb1 : it.qb0; BlockRef r;
    r.Q = Q + ((size_t)it.bh * SEQ + (size_t)qb * QB) * D; r.K = K + (size_t)it.bh * SKV * D;
    r.P0 = 64 + qb * QB; r.row0 = (it.bh >> 4) * SEQ + qb * QB; r.h = it.bh & 15; return r;
}
__device__ __forceinline__ void attn_phase(char* lds, const bf16_t* Q, const bf16_t* K, const bf16_t* V, const bf16_t* Zg, bf16_t* G, const float* logf) {
    const int total = 512, stride = gridDim.x;
    int L = blockIdx.x; if (L >= total) return;
    Item it = decode(L); int pass = 0;
    BlockRef cur = mkref(it, 0, Q, K);
    load_nbk(logf + (size_t)it.bh * LTOT, lds);
    Seam S;
    prime(cur, lds, S);
    for (;;) {
        const bool more_pass = pass == 0, more_item = L + stride < total, last = !more_pass && !more_item;
        Item itn = it; int passn = pass + 1, Ln = L;
        if (!more_pass) { passn = 0; Ln = more_item ? L + stride : L; itn = decode(Ln); }
        const BlockRef nxt = last ? cur : mkref(itn, passn, Q, K);
        block(cur, nxt, lds, S, Zg, G);
        if (last) break;
        if (itn.bh != it.bh) load_nbk(logf + (size_t)itn.bh * LTOT, lds);
        cur = nxt; it = itn; pass = passn; L = Ln;
    }
}
#undef VMW
#undef SBAR
#undef KSWZ
}

__device__ __forceinline__ f32x4 wave_gemm16(const bf16_t* __restrict__ A, int lda, const bf16_t* __restrict__ Bt, int ldb, int K, int lane) {
    const int fr = lane & 15, fq = lane >> 4;
    const bf16_t* ap = A + (size_t)fr * lda + fq * 8; const bf16_t* bp = Bt + (size_t)fr * ldb + fq * 8;
    f32x4 acc = {0.f, 0.f, 0.f, 0.f};
#pragma unroll 8
    for (int k0 = 0; k0 < K; k0 += 32) {
        const bf16x8 a = *(const bf16x8*)(ap + k0), b = *(const bf16x8*)(bp + k0);
        acc = __builtin_amdgcn_mfma_f32_16x16x32_bf16(a, b, acc, 0, 0, 0);
    }
    return acc;
}

#define XB_TMO      128
#define XB_XCNT(j)  (256  + 64 * (j))
#define XB_XSUB(j)  (1280 + 64 * (j))
#define XB_XGEN(j)  (2304 + 64 * (j))
#define XB_TOP      3328
#define XB_TOPGEN   3392
#define XCD_BAR_WORDS 3456
#define XB_SPIN_CAP (1u << 18)
__device__ __forceinline__ unsigned xb_ld(unsigned* p)              { return __hip_atomic_load(p, __ATOMIC_RELAXED, __HIP_MEMORY_SCOPE_AGENT); }
__device__ __forceinline__ unsigned xb_add(unsigned* p, unsigned v) { return __hip_atomic_fetch_add(p, v, __ATOMIC_RELAXED, __HIP_MEMORY_SCOPE_AGENT); }
__device__ __forceinline__ unsigned xb_xcc_id() { return (unsigned)__builtin_amdgcn_s_getreg((3 << 11) | 20) & 0xFu; }
#define XB_SPIN(cond, bar) do { unsigned _sp = 0; while (cond) { __builtin_amdgcn_s_sleep(1); \
    if ((++_sp & 255u) == 0u) { if (xb_ld(&(bar)[XB_TMO])) break; if (_sp > XB_SPIN_CAP) { atomicAdd(&(bar)[XB_TMO], 1u); break; } } } } while (0)
struct XcdBarrier { unsigned* bar; unsigned x; volatile LAS unsigned* st; };
__device__ __forceinline__ XcdBarrier xcd_barrier_post(unsigned* bar, volatile LAS unsigned* st) {
    XcdBarrier b; b.bar = bar; b.x = xb_xcc_id(); b.st = st;
    if (threadIdx.x == 0) (void)xb_add(&bar[XB_XCNT(b.x)], 1u);
    return b;
}
__device__ __forceinline__ void xcd_barrier_complete(unsigned* bar, unsigned x, unsigned& nloc, unsigned& nx) {
    const unsigned G = gridDim.x * gridDim.y * gridDim.z;
    unsigned sum, cnt, mine, sp = 0u;
    for (;;) {
        sum = 0u; cnt = 0u; mine = 0u;
#pragma unroll
        for (unsigned j = 0; j < 16; ++j) { const unsigned c = xb_ld(&bar[XB_XCNT(j)]); sum += c; cnt += (c > 0u) ? 1u : 0u; mine = (j == x) ? c : mine; }
        if (sum == G) break;
        __builtin_amdgcn_s_sleep(1);
        if ((++sp & 255u) == 0u) { if (xb_ld(&bar[XB_TMO])) break; if (sp > XB_SPIN_CAP) { atomicAdd(&bar[XB_TMO], 1u); break; } }
    }
    nloc = mine > 0u ? mine : 1u; nx = cnt > 0u ? cnt : 1u;
}
__device__ __forceinline__ void xcd_barrier(const XcdBarrier& b) {
    asm volatile("s_waitcnt vmcnt(0)" ::: "memory");
    __syncthreads();
    if (threadIdx.x == 0) {
        unsigned* bar = b.bar;
        __builtin_amdgcn_s_waitcnt(0);
        unsigned nloc = b.st[0], nx = b.st[1];
        if (nloc == 0u) { xcd_barrier_complete(bar, b.x, nloc, nx); b.st[0] = nloc; b.st[1] = nx; }
        const unsigned old = xb_add(&bar[XB_XSUB(b.x)], 1u);
        const unsigned gen = old / nloc;
        if (old + 1u == (gen + 1u) * nloc) {
            __builtin_amdgcn_fence(__ATOMIC_RELEASE, "agent");
            asm volatile("s_waitcnt vmcnt(0)" ::: "memory");
            const unsigned og = xb_add(&bar[XB_TOP], 1u);
            const unsigned tg = og / nx;
            if (og + 1u == (tg + 1u) * nx) xb_add(&bar[XB_TOPGEN], 1u);
            else XB_SPIN(xb_ld(&bar[XB_TOPGEN]) == tg, bar);
            __builtin_amdgcn_fence(__ATOMIC_ACQUIRE, "agent");
            xb_add(&bar[XB_XGEN(b.x)], 1u);
            asm volatile("s_waitcnt vmcnt(0)" ::: "memory");
        } else {
            XB_SPIN(xb_ld(&bar[XB_XGEN(b.x)]) == gen, bar);
            __builtin_amdgcn_fence(__ATOMIC_ACQUIRE, "agent");
            asm volatile("s_waitcnt vmcnt(0)" ::: "memory");
        }
    }
    __syncthreads();
}

struct Args {
    const float* x; const float* meta; const float* w_in; const float* b_f; const float* w_out; const float* ln0_g; const float* ln0_b;
    const float* pw_in; const float* pw_grp; const float* p_scale; const float* pw_out; const float* ln1_g; const float* ln1_b;
    float* out; unsigned char* ws; int ph_lo, ph_hi;
};
constexpr int N_PHASES = 10;

__device__ __forceinline__ void p0_transpose_item(const float* __restrict__ W, int K, int ldw, int nblk, bf16_t* __restrict__ WT, LAS float* scr, int item, int lane) {
    const int kb = item / nblk, nb = item % nblk, k0 = 64 * kb, n0 = 32 * nb;
#pragma unroll 8
    for (int i = 0; i < 32; ++i) { const int kk = 2 * i + (lane >> 5); scr[kk * 33 + (lane & 31)] = W[(size_t)(k0 + kk) * ldw + n0 + (lane & 31)]; }
    LDS_WAIT(); asm volatile("" ::: "memory");
    const int c = lane & 7;
#pragma unroll
    for (int j = 0; j < 4; ++j) { const int n = (lane >> 3) + 8 * j; const LAS float* s = scr + (8 * c) * 33 + n;
        u32x4 o; o.x = cvt_pk_bf16(s[0 * 33], s[1 * 33]); o.y = cvt_pk_bf16(s[2 * 33], s[3 * 33]); o.z = cvt_pk_bf16(s[4 * 33], s[5 * 33]); o.w = cvt_pk_bf16(s[6 * 33], s[7 * 33]);
        *(u32x4*)(WT + (size_t)(n0 + n) * K + k0 + 8 * c) = o; }
    LDS_WAIT(); asm volatile("" ::: "memory");
}
__device__ __forceinline__ void row_to_bf16(const float* __restrict__ xrow, bf16_t* __restrict__ orow, int lane) {
    const f32x4* xr = (const f32x4*)xrow + lane; u32x2* o8 = (u32x2*)orow + lane;
    f32x4 v[8];
#pragma unroll
    for (int j = 0; j < 8; ++j) v[j] = xr[64 * j];
#pragma unroll
    for (int j = 0; j < 8; ++j) { u32x2 w; w.x = cvt_pk_bf16(v[j][0], v[j][1]); w.y = cvt_pk_bf16(v[j][2], v[j][3]); o8[64 * j] = w; }
}
__device__ __forceinline__ void ln_row(const float* __restrict__ trow, const float* __restrict__ g, const float* __restrict__ bb, bf16_t* ob, float* of, float* st, int lane) {
    const f32x4* xr = (const f32x4*)trow + lane;
    f32x4 v[8]; float s = 0.f;
#pragma unroll
    for (int j = 0; j < 8; ++j) { v[j] = xr[64 * j]; s += (v[j][0] + v[j][1]) + (v[j][2] + v[j][3]); }
    const float mean = wave_sum(s) * (1.f / DM); float s2 = 0.f;
#pragma unroll
    for (int j = 0; j < 8; ++j) { const f32x4 d = v[j] - mean; s2 += (d[0] * d[0] + d[1] * d[1]) + (d[2] * d[2] + d[3] * d[3]); }
    const float rstd = 1.0f / sqrtf(wave_sum(s2) * (1.f / DM) + LN_EPS);
    if (st && lane == 0) { st[0] = mean; st[1] = rstd; }
#pragma unroll
    for (int j = 0; j < 8; ++j) {
        const f32x4 gv = ((const f32x4*)g)[lane + 64 * j], bv = ((const f32x4*)bb)[lane + 64 * j];
        const f32x4 y = (v[j] - mean) * rstd * gv + bv;
        if (of) ((f32x4*)of)[lane + 64 * j] = y;
        if (ob) { u32x2 w; w.x = cvt_pk_bf16(y[0], y[1]); w.y = cvt_pk_bf16(y[2], y[3]); ((u32x2*)ob)[lane + 64 * j] = w; }
    }
}

__global__ void __launch_bounds__(512, 2) fwd(Args a) {
    extern __shared__ __attribute__((aligned(16))) unsigned char lds[];
    const int tid = threadIdx.x, lane = tid & 63, wid = __builtin_amdgcn_readfirstlane(tid >> 6);
    const int G = gridDim.x, bx = blockIdx.x;
    const int gw = bx * 8 + wid, NGW = G * 8;
    unsigned char* ws = a.ws;
    float* LOGF = (float*)(ws + WS_LOGF); bf16_t* MB = (bf16_t*)(ws + WS_MB); float* PM = (float*)(ws + WS_PM); bf16_t* GM = (bf16_t*)(ws + WS_GM);
    float* T0M = (float*)(ws + WS_T0M); bf16_t* H1MB = (bf16_t*)(ws + WS_H1MB); float* UM = (float*)(ws + WS_UM); float* STATS = (float*)(ws + WS_STATS);
    bf16_t* W1T = (bf16_t*)(ws + WS_W1T); bf16_t* WOT = (bf16_t*)(ws + WS_WOT); bf16_t* WPT = (bf16_t*)(ws + WS_WPT); bf16_t* WGT = (bf16_t*)(ws + WS_WGT); bf16_t* WO2T = (bf16_t*)(ws + WS_WO2T);
    bf16_t* H0B = (bf16_t*)(ws + WS_H0B); bf16_t* GB = H0B; bf16_t* EB = H0B;
    bf16_t* QB_ = (bf16_t*)(ws + WS_Q); bf16_t* H1B = QB_;
    bf16_t* KB_ = (bf16_t*)(ws + WS_K); bf16_t* UB = KB_;
    bf16_t* VB_ = (bf16_t*)(ws + WS_V); bf16_t* Z1B = VB_;
    bf16_t* ZB = (bf16_t*)(ws + WS_Z); bf16_t* DPB = ZB;
    const int lo = a.ph_lo, hi = a.ph_hi;
    volatile LAS unsigned* bst = (volatile LAS unsigned*)((LAS unsigned char*)lds + 131072);
    if (tid < 2) bst[tid] = 0u;
    __syncthreads();
    unsigned* BARW = (unsigned*)ws;
    XcdBarrier bar; bar.bar = BARW; bar.x = 0; bar.st = bst;
#ifdef ONLY_PHASE
#define IN(k) ((k) == ONLY_PHASE && lo <= (k) && (k) < hi)
#else
#define IN(k) (lo <= (k) && (k) < hi)
#endif
#define SEAM(k) do { if (IN(k) && IN((k) + 1)) { if ((k) == 0) { cg::this_grid().sync(); bar = xcd_barrier_post(BARW, bst); } else xcd_barrier(bar); } } while (0)

    if (IN(0)) {
        if (bx == 0) for (int e = tid; e < XCD_BAR_WORDS; e += 512) BARW[e] = 0u;
        LAS float* scr = (LAS float*)((LAS unsigned char*)lds + wid * 8448);
        constexpr int I1 = 32 * 256, IO = 32 * 64, IP = 32 * 128, IG1 = 8 * 16, IO2 = 32 * 64;
        constexpr int NITEMS = I1 + IO + IP + 4 * IG1 + IO2;
        for (int it = gw; it < NITEMS; it += NGW) {
            int r = it;
            if (r < I1) { p0_transpose_item(a.w_in, DM, N1F, 256, W1T, scr, r, lane); continue; } r -= I1;
            if (r < IO) { p0_transpose_item(a.w_out, DM, DM, 64, WOT, scr, r, lane); continue; } r -= IO;
            if (r < IP) { p0_transpose_item(a.pw_in, DM, 2 * DM, 128, WPT, scr, r, lane); continue; } r -= IP;
            if (r < 4 * IG1) { const int gq = r / IG1; p0_transpose_item(a.pw_grp + (size_t)gq * 512 * 512, 512, 512, 16, WGT + (size_t)gq * 512 * 512, scr, r % IG1, lane); continue; } r -= 4 * IG1;
            p0_transpose_item(a.pw_out, DM, DM, 64, WO2T, scr, r, lane);
        }
        for (int e = bx * 512 + tid; e < 16 * DM; e += G * 512) { const int k = e >> 4, n = e & 15; const float w = a.w_in[(size_t)k * N1F + N1 + n];
            W1T[(size_t)(N1 + n) * DM + k] = (bf16_t)(cvt_pk_bf16(w, 0.f) & 0xffffu); }
        for (int m = gw; m < M; m += NGW) row_to_bf16(a.x + (size_t)m * DM, H0B + (size_t)m * DM, lane);
        for (int m = gw; m < NMETA; m += NGW) row_to_bf16(a.meta + (size_t)m * DM, MB + (size_t)m * DM, lane);
        for (int e = bx * 512 + tid; e < NB * NH * 768 * 2; e += G * 512) { const int kv = e & 1, r = e >> 1, bh = r / 768, c = r % 768;
            u32x4 z = {0u, 0u, 0u, 0u}; *(u32x4*)((kv ? VB_ : KB_) + ((size_t)bh * SKV + 16) * HD + (size_t)c * 8) = z; }
    }
    SEAM(0);

    if (IN(1)) {
        const int fr = lane & 15, fq = lane >> 4;
        for (int t = gw; t < 513 + 1024; t += NGW) {
            if (t < 513) {
                const f32x4 acc = wave_gemm16(MB, DM, W1T + (size_t)t * 16 * DM, DM, DM, lane);
                const int n = t * 16 + fr;
#pragma unroll
                for (int i = 0; i < 4; ++i) {
                    const int r = 4 * fq + i; PM[(size_t)r * N1F + n] = acc[i];
                    if (n >= 2048 && n < 6144) { const int kv = n >= 4096, cc = n - (kv ? 4096 : 2048), h = cc >> 7, d = cc & 127; const bf16_t v = (bf16_t)(cvt_pk_bf16(acc[i], 0.f) & 0xffffu);
#pragma unroll
                        for (int b = 0; b < NB; ++b) (kv ? VB_ : KB_)[((size_t)(b * NH + h) * SKV + r) * HD + d] = v; }
                    if (n >= N1) { const float lf = logsig_f(acc[i] + a.b_f[fr]);
#pragma unroll
                        for (int b = 0; b < NB; ++b) LOGF[(size_t)(b * NH + fr) * LTOT + r] = lf; }
                }
            } else {
                const int t2 = t - 513;
                const f32x4 acc = wave_gemm16(H0B + (size_t)t2 * 16 * DM, DM, W1T + (size_t)N1 * DM, DM, DM, lane);
                const float bf = a.b_f[fr];
#pragma unroll
                for (int i = 0; i < 4; ++i) { const int row = t2 * 16 + 4 * fq + i, b = row >> 12, ii = row & 4095;
                    LOGF[(size_t)(b * NH + fr) * LTOT + NMETA + ii] = logsig_f(acc[i] + bf); }
            }
        }
        pg8::Gemm g{H0B, W1T, DM, DM, DM, 0}; pg8::StaticOrder S; S.init(M, N1, G, bx);
        pg8::EpiQKVZ E{QB_, KB_, VB_, ZB};
        pg8::gemm_phase<pg8::EpiQKVZ, pg8::StaticOrder, true>((LAS unsigned char*)lds, g, S, E);
    }
    SEAM(1);

    if (IN(2)) {
        for (int task = gw; task < 256; task += NGW) {
            const int h = task >> 4, i = task & 15; const float bf = a.b_f[h];
            const float q0 = PM[(size_t)i * N1F + h * HD + 2 * lane], q1 = PM[(size_t)i * N1F + h * HD + 2 * lane + 1];
            float ci = 0.f; for (int p = 0; p <= i; ++p) ci += logsig_f(PM[(size_t)p * N1F + N1 + h] + bf);
            float cj = 0.f, mx = -1e30f, l = 0.f, o0 = 0.f, o1 = 0.f;
            for (int j = 0; j <= i; ++j) {
                cj += logsig_f(PM[(size_t)j * N1F + N1 + h] + bf);
                const float k0 = PM[(size_t)j * N1F + 2048 + h * HD + 2 * lane], k1 = PM[(size_t)j * N1F + 2048 + h * HD + 2 * lane + 1];
                const float s = wave_sum(q0 * k0 + q1 * k1) * ATT_SCALE + ci - cj;
                const float mn = fmaxf(mx, s), al = __expf(mx - mn), p = __expf(s - mn);
                const float v0 = PM[(size_t)j * N1F + 4096 + h * HD + 2 * lane], v1 = PM[(size_t)j * N1F + 4096 + h * HD + 2 * lane + 1];
                l = l * al + p; o0 = o0 * al + p * v0; o1 = o1 * al + p * v1; mx = mn;
            }
            const float z0 = PM[(size_t)i * N1F + 6144 + h * HD + 2 * lane], z1 = PM[(size_t)i * N1F + 6144 + h * HD + 2 * lane + 1];
            const float rl = 1.0f / l;
            *(unsigned*)(GM + (size_t)i * DM + h * HD + 2 * lane) = cvt_pk_bf16(o0 * rl * silu_f(z0), o1 * rl * silu_f(z1));
        }
        att::attn_phase((char*)lds, QB_, KB_, VB_, ZB, GB, LOGF);
    }
    SEAM(2);

    if (IN(3)) {
        const int fr = lane & 15, fq = lane >> 4;
        for (int t = gw; t < 128; t += NGW) {
            const f32x4 acc = wave_gemm16(GM, DM, WOT + (size_t)t * 16 * DM, DM, DM, lane);
#pragma unroll
            for (int i = 0; i < 4; ++i) { const int r = 4 * fq + i, n = t * 16 + fr; T0M[(size_t)r * DM + n] = ALPHA * a.meta[(size_t)r * DM + n] + acc[i]; }
        }
        pg8::Gemm g{GB, WOT, DM, DM, DM, 0}; pg8::StaticOrder S; S.init(M, DM, G, bx);
        pg8::EpiT0 E{a.x, a.out};
        pg8::gemm_phase<pg8::EpiT0, pg8::StaticOrder, true>((LAS unsigned char*)lds, g, S, E);
    }
    SEAM(3);

    if (IN(4)) {
        for (int m = gw; m < M + NMETA; m += NGW) {
            if (m < M) ln_row(a.out + (size_t)m * DM, a.ln0_g, a.ln0_b, H1B + (size_t)m * DM, nullptr, STATS + 2 * (size_t)m, lane);
            else ln_row(T0M + (size_t)(m - M) * DM, a.ln0_g, a.ln0_b, H1MB + (size_t)(m - M) * DM, nullptr, nullptr, lane);
        }
    }
    SEAM(4);

    if (IN(5)) {
        const int fr = lane & 15, fq = lane >> 4;
        for (int t = gw; t < 128; t += NGW) {
            const f32x4 acc = wave_gemm16(H1MB, DM, WPT + (size_t)t * 16 * DM, DM, DM, lane);
#pragma unroll
            for (int i = 0; i < 4; ++i) UM[(size_t)(4 * fq + i) * DM + t * 16 + fr] = acc[i];
        }
        pg8::Gemm g{H1B, WPT, DM, DM, DM, 0}; pg8::StaticOrder S; S.init(M, 2 * DM, G, bx);
        pg8::EpiSplit2 E{UB, Z1B};
        pg8::gemm_phase<pg8::EpiSplit2, pg8::StaticOrder, true>((LAS unsigned char*)lds, g, S, E);
    }
    SEAM(5);

    if (IN(6)) {
        for (int it = bx * 512 + tid; it < (M / 32) * 256; it += G * 512) {
            const int chunk = it & 255, run = it >> 8, c0 = chunk * 8, gq = c0 >> 9, w = 2 << gq; const float invw = 1.0f / (float)w;
            const int row0 = run * 32, b = row0 >> 12, i0 = row0 & 4095;
            const bf16_t* Ub = UB + (size_t)(b * SEQ) * DM + c0; const float* Um = UM + c0;
            float sum[8];
#pragma unroll
            for (int e = 0; e < 8; ++e) sum[e] = 0.f;
            for (int j = 1; j < w; ++j) { const int i = i0 - j;
                if (i >= 0) { const u32x4 q = *(const u32x4*)(Ub + (size_t)i * DM);
                    sum[0] += bflo(q.x); sum[1] += bfhi(q.x); sum[2] += bflo(q.y); sum[3] += bfhi(q.y); sum[4] += bflo(q.z); sum[5] += bfhi(q.z); sum[6] += bflo(q.w); sum[7] += bfhi(q.w); }
                else { const f32x4 p0 = *(const f32x4*)(Um + (size_t)(16 + i) * DM), p1 = *(const f32x4*)(Um + (size_t)(16 + i) * DM + 4);
                    sum[0] += p0[0]; sum[1] += p0[1]; sum[2] += p0[2]; sum[3] += p0[3]; sum[4] += p1[0]; sum[5] += p1[1]; sum[6] += p1[2]; sum[7] += p1[3]; } }
#pragma unroll 4
            for (int s = 0; s < 32; ++s) { const int i = i0 + s;
                const u32x4 q = *(const u32x4*)(Ub + (size_t)i * DM);
                float f[8] = {bflo(q.x), bfhi(q.x), bflo(q.y), bfhi(q.y), bflo(q.z), bfhi(q.z), bflo(q.w), bfhi(q.w)};
                float d[8];
#pragma unroll
                for (int e = 0; e < 8; ++e) { sum[e] += f[e]; d[e] = sum[e] * invw - f[e]; }
                u32x4 o; o.x = cvt_pk_bf16(d[0], d[1]); o.y = cvt_pk_bf16(d[2], d[3]); o.z = cvt_pk_bf16(d[4], d[5]); o.w = cvt_pk_bf16(d[6], d[7]);
                *(u32x4*)(DPB + (size_t)(row0 + s) * DM + c0) = o;
                const int io = i - w + 1;
                if (io >= 0) { const u32x4 r = *(const u32x4*)(Ub + (size_t)io * DM);
                    sum[0] -= bflo(r.x); sum[1] -= bfhi(r.x); sum[2] -= bflo(r.y); sum[3] -= bfhi(r.y); sum[4] -= bflo(r.z); sum[5] -= bfhi(r.z); sum[6] -= bflo(r.w); sum[7] -= bfhi(r.w); }
                else { const f32x4 p0 = *(const f32x4*)(Um + (size_t)(16 + io) * DM), p1 = *(const f32x4*)(Um + (size_t)(16 + io) * DM + 4);
                    sum[0] -= p0[0]; sum[1] -= p0[1]; sum[2] -= p0[2]; sum[3] -= p0[3]; sum[4] -= p1[0]; sum[5] -= p1[1]; sum[6] -= p1[2]; sum[7] -= p1[3]; } }
        }
    }
    SEAM(6);

    if (IN(7)) {
        pg8::Gemm g{DPB, WGT, DM, 512, 512, 2}; pg8::StaticOrder S; S.init(M, DM, G, bx);
        pg8::EpiGate E{Z1B, a.p_scale, EB};
        pg8::gemm_phase<pg8::EpiGate, pg8::StaticOrder, true>((LAS unsigned char*)lds, g, S, E);
    }
    SEAM(7);

    if (IN(8)) {
        pg8::Gemm g{EB, WO2T, DM, DM, DM, 0}; pg8::StaticOrder S; S.init(M, DM, G, bx);
        pg8::EpiT1 E{a.out, STATS, a.ln0_g, a.ln0_b};
        pg8::gemm_phase<pg8::EpiT1, pg8::StaticOrder, true>((LAS unsigned char*)lds, g, S, E);
    }
    SEAM(8);

    if (IN(9)) {
        for (int m = gw; m < M; m += NGW) ln_row(a.out + (size_t)m * DM, a.ln1_g, a.ln1_b, nullptr, a.out + (size_t)m * DM, nullptr, lane);
    }
#undef IN
#undef SEAM
}

extern "C" void kernel_launch(void* const* d_in, const int* in_sizes, int n_in, void* d_out, int out_size, void* d_ws, size_t ws_size, hipStream_t stream) {
    static int grid = 0;
    if (grid == 0) {
        if (n_in != 13 || in_sizes[0] != M * DM || out_size != M * DM || ws_size < WS_END) { fprintf(stderr, "kernel_launch: shape/workspace mismatch (n_in %d, in0 %d, out %d, ws %zu)\n", n_in, n_in > 0 ? in_sizes[0] : -1, out_size, ws_size); grid = -1; return; }
        int dev = 0, cus = 0, per_cu = 0;
        (void)hipGetDevice(&dev); (void)hipDeviceGetAttribute(&cus, hipDeviceAttributeMultiprocessorCount, dev);
        if (hipFuncSetAttribute((const void*)fwd, hipFuncAttributeMaxDynamicSharedMemorySize, LDS_BYTES) != hipSuccess) { fprintf(stderr, "kernel_launch: hipFuncSetAttribute failed\n"); grid = -1; return; }
        if (hipOccupancyMaxActiveBlocksPerMultiprocessor(&per_cu, (const void*)fwd, 512, LDS_BYTES) != hipSuccess || per_cu < 1) { fprintf(stderr, "kernel_launch: occupancy query says %d\n", per_cu); per_cu = 1; }
        (void)hipGetLastError();
        grid = cus * 1;
        if (grid <= 0) grid = 256;
    }
    if (grid < 0) return;
    Args a{};
    a.x = (const float*)d_in[0]; a.meta = (const float*)d_in[1]; a.w_in = (const float*)d_in[2]; a.b_f = (const float*)d_in[3]; a.w_out = (const float*)d_in[4];
    a.ln0_g = (const float*)d_in[5]; a.ln0_b = (const float*)d_in[6]; a.pw_in = (const float*)d_in[7]; a.pw_grp = (const float*)d_in[8]; a.p_scale = (const float*)d_in[9];
    a.pw_out = (const float*)d_in[10]; a.ln1_g = (const float*)d_in[11]; a.ln1_b = (const float*)d_in[12];
    a.out = (float*)d_out; a.ws = (unsigned char*)d_ws;
#if MK_N_LAUNCHES == 1
    a.ph_lo = 0; a.ph_hi = N_PHASES;
    void* args[] = {&a};
    hipError_t e = hipLaunchCooperativeKernel((const void*)fwd, dim3(grid), dim3(512), args, LDS_BYTES, stream);
    if (e != hipSuccess) fprintf(stderr, "kernel_launch: cooperative launch failed: %s (grid %d)\n", hipGetErrorString(e), grid);
#else
    for (int p = 0; p < N_PHASES; ++p) for (int rep = 0; rep < (p == PROBE_DUP ? 2 : 1); ++rep) { a.ph_lo = p; a.ph_hi = p + 1; hipLaunchKernelGGL(fwd, dim3(grid), dim3(512), LDS_BYTES, stream, a); }
#endif
}
```

```cpp
#include <hip/hip_runtime.h>
#include <hip/hip_cooperative_groups.h>
#include <cstdio>
#include <cstdint>
namespace cg = cooperative_groups;

#ifndef MK_N_LAUNCHES
#define MK_N_LAUNCHES 1
#endif

#ifndef PROBE_DUP
#define PROBE_DUP -1
#endif
#define LAS __attribute__((address_space(3)))
typedef unsigned short bf16_t;
typedef short bf16x8 __attribute__((ext_vector_type(8)));
typedef short s16x4 __attribute__((ext_vector_type(4)));
typedef float f32x4 __attribute__((ext_vector_type(4)));
typedef float f32x2 __attribute__((ext_vector_type(2)));
typedef float f32x16 __attribute__((ext_vector_type(16)));
typedef unsigned u32x4 __attribute__((ext_vector_type(4)));
typedef unsigned u32x2 __attribute__((ext_vector_type(2)));

constexpr int DM = 2048, NB = 4, SEQ = 4096, NMETA = 16, NH = 16, HD = 128;
constexpr int M = NB * SEQ;
constexpr int LTOT = SEQ + NMETA;
constexpr int SKV = SEQ + 64;
constexpr int N1 = 8192, N1F = 8208;
constexpr float ALPHA = 1.4142135623730951f;
constexpr float LN_EPS = 1e-5f;
constexpr float ATT_SCALE = 0.08838834764831845f;

constexpr size_t MiB = 1u << 20;
constexpr size_t WS_LOGF = 1 * MiB;
constexpr size_t WS_MB = 3 * MiB;
constexpr size_t WS_PM = 3 * MiB + 256 * 1024;
constexpr size_t WS_GM = 4 * MiB;
constexpr size_t WS_T0M = 4 * MiB + 64 * 1024;
constexpr size_t WS_H1MB = 4 * MiB + 192 * 1024;
constexpr size_t WS_UM = 4 * MiB + 256 * 1024;
constexpr size_t WS_STATS = 5 * MiB;
constexpr size_t WS_W1T = 8 * MiB;
constexpr size_t WS_WOT = 41 * MiB;
constexpr size_t WS_WPT = 49 * MiB;
constexpr size_t WS_WGT = 65 * MiB;
constexpr size_t WS_WO2T = 67 * MiB;
constexpr size_t WS_H0B = 76 * MiB;
constexpr size_t WS_Q = 140 * MiB;
constexpr size_t WS_K = 204 * MiB;
constexpr size_t WS_V = 269 * MiB;
constexpr size_t WS_Z = 334 * MiB;
constexpr size_t WS_END = 398 * MiB;

constexpr int LDS_BYTES = 135168;

__device__ __forceinline__ unsigned cvt_pk_bf16(float lo, float hi) { unsigned r; asm volatile("v_cvt_pk_bf16_f32 %0, %1, %2" : "=v"(r) : "v"(lo), "v"(hi)); return r; }
__device__ __forceinline__ float bf2f(unsigned short v) { return __uint_as_float((unsigned)v << 16); }
__device__ __forceinline__ float bflo(unsigned w) { return __uint_as_float(w << 16); }
__device__ __forceinline__ float bfhi(unsigned w) { return __uint_as_float(w & 0xffff0000u); }
__device__ __forceinline__ float silu_f(float z) { return z * __builtin_amdgcn_rcpf(1.0f + __expf(-z)); }
__device__ __forceinline__ float logsig_f(float x) { return fminf(x, 0.f) - log1pf(expf(-fabsf(x))); }
__device__ __forceinline__ float wave_sum(float v) {
#pragma unroll
    for (int o = 1; o < 64; o <<= 1) v += __shfl_xor(v, o);
    return v;
}
#define LDS_WAIT() asm volatile("s_waitcnt lgkmcnt(0)" ::: "memory")

namespace pg8 {
constexpr int BM = 256, BK = 64, HALF = 128, HTB = HALF * BK * 2, STAGE_BYTES = 8 * HTB, NXCD = 8, WGM = 8;
__host__ __device__ __forceinline__ int lds_byte(int r, int c) { const int st = (r >> 4) * 2 + (c >> 5), rr = r & 15, cc = c & 31, ob = rr * 64 + cc * 2; return st * 1024 + (ob ^ (((ob >> 9) & 1) << 5)); }
__host__ __device__ __forceinline__ void stage_rc(int b, int& R, int& C) { const int st = b / 1024, sb = b % 1024, swz = sb ^ (((sb >> 9) & 1) << 5); R = (st >> 1) * 16 + swz / 64; C = (st & 1) * 32 + (swz % 64) / 2; }
__host__ __device__ __forceinline__ int perm32(int rho) { const int n = rho >> 4, i = rho & 15; return 8 * (i >> 2) + 4 * n + (i & 3); }

struct Unit { int pm, pn; };
struct Gemm { const bf16_t* A; const bf16_t* Bt; int lda, ldb, K, grp; };

struct StaticOrder {
    int nM, nN, nwg, G, c;
    __host__ __device__ void init(int M_, int N_, int G_, int c_) { nM = M_ / BM; nN = N_ / BM; nwg = nM * nN; G = G_; c = c_; }
    __host__ __device__ bool next(int i, Unit& u) const {
        const long L = (long)i * G + c; if (L >= nwg) return false;
        int wgid = (int)L; { const int q = nwg / NXCD, r = nwg % NXCD, xcd = wgid % NXCD, off = wgid / NXCD; wgid = (xcd < r ? xcd * (q + 1) : r * (q + 1) + (xcd - r) * q) + off; }
        const int nig = WGM * nN, gid = wgid / nig, fm = gid * WGM, gsz = (nM - fm) < WGM ? (nM - fm) : WGM;
        u.pm = fm + ((wgid % nig) % gsz); u.pn = (wgid % nig) / gsz; return true;
    }
};

template <class Epi, class Sched, bool ALIGN_EPI>
__device__ __forceinline__ void gemm_phase(LAS unsigned char* lds, const Gemm g, const Sched& S, const Epi& E) {
    const int tid = threadIdx.x, wid = __builtin_amdgcn_readfirstlane(tid >> 6), lane = tid & 63, wr = wid >> 2, wc = wid & 3, fr = lane & 15, fq = lane >> 4;
    const int K = g.K, nt = K / BK;
    unsigned voffA[2], voffB[2];
#pragma unroll
    for (int i = 0; i < 2; ++i) { int R, C; stage_rc(tid * 16 + i * 8192, R, C); const int Rb = Epi::PERM ? ((R & ~31) + perm32(R & 31)) : R;
        voffA[i] = (unsigned)(R * g.lda + C) * 2u; voffB[i] = (unsigned)(Rb * g.ldb + C) * 2u; }
    const size_t kstep = (size_t)(BK * 2);
    const size_t hA = (size_t)HALF * g.lda * 2, hB = (size_t)HALF * g.ldb * 2;
    const unsigned ldsw = (unsigned)wid * 1024u;
    const int aoff = lds_byte(wr * 64 + fr, fq * 8), boff = lds_byte(wc * 32 + fr, fq * 8);
#define PG8_SA(b, h) (((b) * 2 + (h)) * HTB)
#define PG8_SB(b, h) ((4 + (b) * 2 + (h)) * HTB)
#define PG8_STAGE(bufoff, gbase, voff) do { _Pragma("unroll") for (int _i = 0; _i < 2; ++_i) \
        __builtin_amdgcn_global_load_lds((const unsigned*)((const char*)(gbase) + (voff)[_i]), (LAS unsigned*)(lds + (bufoff) + ldsw + _i * 8192), 16, 0, 0); } while (0)
#define PG8_LDA(dst, b, h) do { _Pragma("unroll") for (int m = 0; m < 4; ++m) _Pragma("unroll") for (int k = 0; k < 2; ++k) dst[m][k] = *(const LAS bf16x8*)(lds + PG8_SA(b, h) + aoff + m * 2048 + k * 1024); } while (0)
#define PG8_LDB(dst, b, h) do { _Pragma("unroll") for (int n = 0; n < 2; ++n) _Pragma("unroll") for (int k = 0; k < 2; ++k) dst[n][k] = *(const LAS bf16x8*)(lds + PG8_SB(b, h) + boff + n * 2048 + k * 1024); } while (0)
#define PG8_MMA(ai, bj, At, Bt) do { __builtin_amdgcn_s_setprio(1); _Pragma("unroll") for (int m = 0; m < 4; ++m) _Pragma("unroll") for (int n = 0; n < 2; ++n) _Pragma("unroll") for (int k = 0; k < 2; ++k) \
        acc[ai][bj][m][n] = __builtin_amdgcn_mfma_f32_16x16x32_bf16(Bt[n][k], At[m][k], acc[ai][bj][m][n], 0, 0, 0); __builtin_amdgcn_s_setprio(0); } while (0)
#define PG8_WAIT_V(n) asm volatile("s_waitcnt vmcnt(" #n ")" ::: "memory")
#define PG8_WAIT_L(n) asm volatile("s_waitcnt lgkmcnt(" #n ")" ::: "memory")
#define PG8_BAR __builtin_amdgcn_s_barrier()
#define PG8_SCHED __builtin_amdgcn_sched_barrier(0)
#define PG8_UA(u) ((const char*)g.A + (size_t)(u).pm * 2 * hA + (g.grp ? (size_t)((u).pn / g.grp) * (size_t)K * 2 : (size_t)0))
#define PG8_UB(u) ((const char*)g.Bt + (size_t)(u).pn * 2 * hB)
    Unit cur, nxt; int ui = 0;
    if (!S.next(0, cur)) return;
    f32x4 acc[2][2][4][2];
#pragma unroll
    for (int a = 0; a < 2; ++a)
#pragma unroll
        for (int b = 0; b < 2; ++b)
#pragma unroll
            for (int m = 0; m < 4; ++m)
#pragma unroll
                for (int n = 0; n < 2; ++n) acc[a][b][m][n] = (f32x4){0.f, 0.f, 0.f, 0.f};
    bf16x8 At[4][2], B0[2][2], B1[2][2];
    const char* cA = PG8_UA(cur); const char* cB = PG8_UB(cur);
    PG8_STAGE(PG8_SB(0, 0), cB, voffB); PG8_STAGE(PG8_SB(0, 1), cB + hB, voffB); PG8_STAGE(PG8_SA(0, 0), cA, voffA); PG8_STAGE(PG8_SA(0, 1), cA + hA, voffA);
    if (wr == 1) PG8_BAR;
    PG8_WAIT_V(2); PG8_BAR;
    PG8_STAGE(PG8_SB(1, 0), cB + kstep, voffB); PG8_STAGE(PG8_SA(1, 0), cA + kstep, voffA); PG8_STAGE(PG8_SB(1, 1), cB + hB + kstep, voffB);
    PG8_WAIT_V(6); PG8_BAR;
    for (;;) {
        const bool has_next = S.next(ui + 1, nxt);
        const char* nA = has_next ? PG8_UA(nxt) : cA; const char* nB = has_next ? PG8_UB(nxt) : cB;
        for (int t = 0; t < nt; t += 2) {
            const bool last = (t == nt - 2);
            const char* a1 = cA + (size_t)(t + 1) * kstep;
            const char* a2 = last ? nA : cA + (size_t)(t + 2) * kstep; const char* b2 = last ? nB : cB + (size_t)(t + 2) * kstep;
            const char* a3 = a2 + kstep; const char* b3 = b2 + kstep;
            PG8_LDB(B0, 0, 0); PG8_LDB(B1, 0, 1); PG8_SCHED; PG8_LDA(At, 0, 0); PG8_STAGE(PG8_SA(1, 1), a1 + hA, voffA);
            PG8_WAIT_V(8); PG8_WAIT_L(0); PG8_BAR; PG8_MMA(0, 0, At, B0); PG8_MMA(0, 1, At, B1); PG8_BAR; PG8_SCHED;
            PG8_LDA(At, 0, 1); PG8_STAGE(PG8_SB(0, 0), b2, voffB); PG8_STAGE(PG8_SB(0, 1), b2 + hB, voffB); PG8_STAGE(PG8_SA(0, 0), a2, voffA);
            PG8_WAIT_V(8); PG8_WAIT_L(0); PG8_BAR; PG8_MMA(1, 0, At, B0); PG8_MMA(1, 1, At, B1); PG8_BAR; PG8_SCHED;
            PG8_LDB(B0, 1, 0); PG8_LDB(B1, 1, 1); PG8_SCHED; PG8_LDA(At, 1, 0); PG8_STAGE(PG8_SA(0, 1), a2 + hA, voffA);
            PG8_WAIT_V(8); PG8_WAIT_L(0); PG8_BAR; PG8_MMA(0, 0, At, B0); PG8_MMA(0, 1, At, B1); PG8_BAR; PG8_SCHED;
            PG8_LDA(At, 1, 1); PG8_STAGE(PG8_SB(1, 0), b3, voffB); PG8_STAGE(PG8_SB(1, 1), b3 + hB, voffB); PG8_STAGE(PG8_SA(1, 0), a3, voffA);
            PG8_WAIT_V(8); PG8_WAIT_L(0); PG8_BAR; PG8_MMA(1, 0, At, B0); PG8_MMA(1, 1, At, B1); PG8_BAR; PG8_SCHED;
        }
        if constexpr (ALIGN_EPI) { if (wr == 0) PG8_BAR; }
        E(acc, cur, wr, wc, fr, fq);
        if (!has_next) break;
#pragma unroll
        for (int a = 0; a < 2; ++a)
#pragma unroll
            for (int b = 0; b < 2; ++b)
#pragma unroll
                for (int m = 0; m < 4; ++m)
#pragma unroll
                    for (int n = 0; n < 2; ++n) acc[a][b][m][n] = (f32x4){0.f, 0.f, 0.f, 0.f};
        cur = nxt; cA = nA; cB = nB; ++ui;
        if constexpr (ALIGN_EPI) { if (wr == 1) PG8_BAR; }
    }
    PG8_WAIT_V(0);
    if constexpr (!ALIGN_EPI) { if (wr == 0) PG8_BAR; }
    PG8_BAR;
#undef PG8_SA
#undef PG8_SB
#undef PG8_STAGE
#undef PG8_LDA
#undef PG8_LDB
#undef PG8_MMA
#undef PG8_WAIT_V
#undef PG8_WAIT_L
#undef PG8_BAR
#undef PG8_SCHED
#undef PG8_UA
#undef PG8_UB
}

__device__ __forceinline__ u32x4 pack8f(f32x4 a, f32x4 b) { u32x4 w; w.x = cvt_pk_bf16(a[0], a[1]); w.y = cvt_pk_bf16(a[2], a[3]); w.z = cvt_pk_bf16(b[0], b[1]); w.w = cvt_pk_bf16(b[2], b[3]); return w; }

struct EpiQKVZ {
    static constexpr bool PERM = true;
    bf16_t *Q, *Kb, *Vb, *Z;
    __device__ __forceinline__ void operator()(const f32x4 (&acc)[2][2][4][2], const Unit& u, int wr, int wc, int fr, int fq) const {
        const int t = u.pn >> 3, hbase = (u.pn & 7) * 2, d = wc * 32 + 8 * fq;
#pragma unroll
        for (int ai = 0; ai < 2; ++ai)
#pragma unroll
            for (int m = 0; m < 4; ++m) {
                const int row = u.pm * BM + ai * HALF + wr * 64 + m * 16 + fr, b = row >> 12, i = row & 4095;
#pragma unroll
                for (int bj = 0; bj < 2; ++bj) {
                    const int h = hbase + bj; bf16_t* p;
                    if (t == 0) p = Q + ((size_t)((b * NH + h) * SEQ + i)) * HD + d;
                    else if (t == 3) p = Z + (size_t)row * DM + h * HD + d;
                    else p = (t == 1 ? Kb : Vb) + ((size_t)((b * NH + h) * SKV + 64 + i)) * HD + d;
                    *(u32x4*)p = pack8f(acc[ai][bj][m][0], acc[ai][bj][m][1]);
                }
            }
    }
};
struct EpiSplit2 {
    static constexpr bool PERM = true;
    bf16_t *O0, *O1;
    __device__ __forceinline__ void operator()(const f32x4 (&acc)[2][2][4][2], const Unit& u, int wr, int wc, int fr, int fq) const {
        bf16_t* base = (u.pn < 8 ? O0 : O1) + (u.pn & 7) * BM + wc * 32 + 8 * fq;
#pragma unroll
        for (int ai = 0; ai < 2; ++ai)
#pragma unroll
            for (int m = 0; m < 4; ++m) {
                const int row = u.pm * BM + ai * HALF + wr * 64 + m * 16 + fr;
#pragma unroll
                for (int bj = 0; bj < 2; ++bj) *(u32x4*)(base + (size_t)row * DM + bj * HALF) = pack8f(acc[ai][bj][m][0], acc[ai][bj][m][1]);
            }
    }
};
struct EpiT0 {
    static constexpr bool PERM = false;
    const float* X; float* O;
    __device__ __forceinline__ void operator()(const f32x4 (&acc)[2][2][4][2], const Unit& u, int wr, int wc, int fr, int fq) const {
        const int col0 = u.pn * BM + wc * 32 + 4 * fq;
#pragma unroll
        for (int ai = 0; ai < 2; ++ai)
#pragma unroll
            for (int m = 0; m < 4; ++m) {
                const size_t off = (size_t)(u.pm * BM + ai * HALF + wr * 64 + m * 16 + fr) * DM + col0;
#pragma unroll
                for (int bj = 0; bj < 2; ++bj)
#pragma unroll
                    for (int n = 0; n < 2; ++n) { const f32x4 xv = *(const f32x4*)(X + off + bj * HALF + n * 16); *(f32x4*)(O + off + bj * HALF + n * 16) = xv * ALPHA + acc[ai][bj][m][n]; }
            }
    }
};
struct EpiGate {
    static constexpr bool PERM = true;
    const bf16_t* Z1; const float* scale; bf16_t* O;
    __device__ __forceinline__ void operator()(const f32x4 (&acc)[2][2][4][2], const Unit& u, int wr, int wc, int fr, int fq) const {
        const int col0 = u.pn * BM + wc * 32 + 8 * fq;
        f32x4 sv[2][2];
#pragma unroll
        for (int bj = 0; bj < 2; ++bj) { sv[bj][0] = *(const f32x4*)(scale + col0 + bj * HALF); sv[bj][1] = *(const f32x4*)(scale + col0 + bj * HALF + 4); }
#pragma unroll
        for (int ai = 0; ai < 2; ++ai)
#pragma unroll
            for (int m = 0; m < 4; ++m) {
                const size_t off = (size_t)(u.pm * BM + ai * HALF + wr * 64 + m * 16 + fr) * DM + col0;
#pragma unroll
                for (int bj = 0; bj < 2; ++bj) {
                    const u32x4 zw = *(const u32x4*)(Z1 + off + bj * HALF);
                    f32x4 v0 = acc[ai][bj][m][0] * sv[bj][0], v1 = acc[ai][bj][m][1] * sv[bj][1];
                    v0[0] *= silu_f(bflo(zw.x)); v0[1] *= silu_f(bfhi(zw.x)); v0[2] *= silu_f(bflo(zw.y)); v0[3] *= silu_f(bfhi(zw.y));
                    v1[0] *= silu_f(bflo(zw.z)); v1[1] *= silu_f(bfhi(zw.z)); v1[2] *= silu_f(bflo(zw.w)); v1[3] *= silu_f(bfhi(zw.w));
                    *(u32x4*)(O + off + bj * HALF) = pack8f(v0, v1);
                }
            }
    }
};
struct EpiT1 {
    static constexpr bool PERM = false;
    float* T; const float* stats; const float* g; const float* bb;
    __device__ __forceinline__ void operator()(const f32x4 (&acc)[2][2][4][2], const Unit& u, int wr, int wc, int fr, int fq) const {
        const int col0 = u.pn * BM + wc * 32 + 4 * fq;
        f32x4 gv[2][2], bv[2][2];
#pragma unroll
        for (int bj = 0; bj < 2; ++bj)
#pragma unroll
            for (int n = 0; n < 2; ++n) { gv[bj][n] = *(const f32x4*)(g + col0 + bj * HALF + n * 16); bv[bj][n] = *(const f32x4*)(bb + col0 + bj * HALF + n * 16); }
#pragma unroll
        for (int ai = 0; ai < 2; ++ai)
#pragma unroll
            for (int m = 0; m < 4; ++m) {
                const int row = u.pm * BM + ai * HALF + wr * 64 + m * 16 + fr;
                const f32x2 st = *(const f32x2*)(stats + 2 * (size_t)row);
                const size_t off = (size_t)row * DM + col0;
#pragma unroll
                for (int bj = 0; bj < 2; ++bj)
#pragma unroll
                    for (int n = 0; n < 2; ++n) { const f32x4 tv = *(const f32x4*)(T + off + bj * HALF + n * 16);
                        const f32x4 h1 = (tv - st.x) * st.y * gv[bj][n] + bv[bj][n];
                        *(f32x4*)(T + off + bj * HALF + n * 16) = h1 * ALPHA + acc[ai][bj][m][n]; }
            }
    }
};
}

namespace att {
constexpr int D = 128, NW = 8, QBLK = 32, KVBLK = 64, QB = 256;
constexpr int SHM_V = KVBLK * D * 2, SHM_K = KVBLK * D * 2;
constexpr int OFF_WS = 2 * SHM_V + 2 * SHM_K;
constexpr int OFF_NBK = OFF_WS + NW * 64 * 4;
constexpr int OFF_SCAN = OFF_NBK + SKV * 4;
constexpr int ATT_LDS = OFF_SCAN + 64;
constexpr float SCALE = ATT_SCALE;
constexpr float THR = 8.f;
#define KSWZ(row, colB) ((row) * 256 + ((colB) ^ (((row) & 7) << 4)))
#define SBAR() __builtin_amdgcn_sched_barrier(0)
__device__ __forceinline__ int v_st(int k, int c) { const int kk = (k & ~0xC) | ((k & 4) << 1) | ((k & 8) >> 1); return ((kk >> 3) * 4 + (c >> 5)) * 512 + ((kk & 7) * 32 + (c & 31)) * 2; }
__device__ __forceinline__ int v_rd_base(int lane) { return ((lane & 3) << 3) | (((lane >> 2) & 3) << 6) | (((lane >> 4) & 1) << 5) | (((lane >> 5) & 1) << 8); }
constexpr int v_rd_off(int d0, int ks, int half) { return d0 * 512 + ks * 4096 + half * 2048; }
__device__ __forceinline__ int crow(int r, int hi) { return (r & 3) + 8 * (r >> 2) + 4 * hi; }
__device__ __forceinline__ bf16x8 load8(const bf16_t* p) { return *reinterpret_cast<const bf16x8*>(p); }
__device__ __forceinline__ void mask_tile(f32x16& p0, f32x16& p1, int dq) {
    const float NEG = -__builtin_inff();
#pragma unroll
    for (int r = 0; r < 16; ++r) {
        const int c = (r & 3) + 8 * (r >> 2);
        if (dq - c < 0) p0[r] = NEG;
        if (dq - c - 32 < 0) p1[r] = NEG;
    }
}
__device__ __forceinline__ void partialSM(f32x16& p0, f32x16& p1, float& m_reg, float& mn, float& alpha) {
    float pmax = p0[0];
#pragma unroll
    for (int r = 1; r < 16; ++r) pmax = fmaxf(pmax, p0[r]);
#pragma unroll
    for (int r = 0; r < 16; ++r) pmax = fmaxf(pmax, p1[r]);
    { auto rr = __builtin_amdgcn_permlane32_swap(__float_as_uint(pmax), __float_as_uint(pmax), false, false);
      pmax = fmaxf(__uint_as_float(rr[0]), __uint_as_float(rr[1])); }
    constexpr float C2 = 1.4426950408889634f * SCALE;
    if (__builtin_expect(__all((pmax - m_reg) * SCALE <= THR), 1)) { mn = m_reg; alpha = 1.f; }
    else { mn = fmaxf(m_reg, pmax); alpha = __builtin_amdgcn_exp2f((m_reg - mn) * C2); m_reg = mn; }
    const float mnL = -mn * C2;
#pragma unroll
    for (int r = 0; r < 16; ++r) p0[r] = fmaf(p0[r], C2, mnL);
#pragma unroll
    for (int r = 0; r < 16; ++r) p1[r] = fmaf(p1[r], C2, mnL);
#pragma unroll
    for (int r = 0; r < 16; ++r) p0[r] = __builtin_amdgcn_exp2f(p0[r]);
}
__device__ __forceinline__ void finishSM(f32x16& p0, f32x16& p1, float alpha, float& l_reg, bf16x8& pa0, bf16x8& pa1, bf16x8& pa2, bf16x8& pa3) {
#pragma unroll
    for (int r = 0; r < 16; ++r) p1[r] = __builtin_amdgcn_exp2f(p1[r]);
    float ps = 0;
#pragma unroll
    for (int r = 0; r < 16; ++r) ps += p0[r];
#pragma unroll
    for (int r = 0; r < 16; ++r) ps += p1[r];
    { auto rr = __builtin_amdgcn_permlane32_swap(__float_as_uint(ps), __float_as_uint(ps), false, false);
      ps = __uint_as_float(rr[0]) + __uint_as_float(rr[1]); }
    l_reg = l_reg * alpha + ps;
#define PK4(P, B_, OUT) do { unsigned a0 = cvt_pk_bf16(P[B_+0], P[B_+1]), a1 = cvt_pk_bf16(P[B_+2], P[B_+3]);                          \
        unsigned b0 = cvt_pk_bf16(P[B_+4], P[B_+5]), b1 = cvt_pk_bf16(P[B_+6], P[B_+7]);                                             \
        auto r0 = __builtin_amdgcn_permlane32_swap(a0, b0, false, false); auto r1 = __builtin_amdgcn_permlane32_swap(a1, b1, false, false); \
        u32x4 w = {r0[0], r1[0], r0[1], r1[1]}; OUT = *reinterpret_cast<bf16x8*>(&w); } while (0)
    PK4(p0, 0, pa0); PK4(p0, 8, pa1); PK4(p1, 0, pa2); PK4(p1, 8, pa3);
#undef PK4
}
template <int KB>
__device__ __forceinline__ void qkt(f32x16& p0, f32x16& p1, const char* K_lds, const float* nbk_t, int r32, int hi, const bf16x8* qr) {
    const f32x4* bp = (const f32x4*)(nbk_t + 4 * hi);
#pragma unroll
    for (int g = 0; g < 4; ++g) { const f32x4 a = bp[2 * g], b = bp[8 + 2 * g];
        p0[4 * g] = a[0]; p0[4 * g + 1] = a[1]; p0[4 * g + 2] = a[2]; p0[4 * g + 3] = a[3];
        p1[4 * g] = b[0]; p1[4 * g + 1] = b[1]; p1[4 * g + 2] = b[2]; p1[4 * g + 3] = b[3]; }
    const char* kb[4];
#pragma unroll
    for (int dd = 0; dd < 4; ++dd) kb[dd] = K_lds + KB * SHM_K + KSWZ(r32, (dd * 16 + hi * 8) * 2);
#pragma unroll
    for (int d0 = 0; d0 < 8; ++d0) { const char* a = kb[d0 & 3] + (d0 >> 2) * 128;
        bf16x8 b0 = *reinterpret_cast<const bf16x8*>(a);
        bf16x8 b1 = *reinterpret_cast<const bf16x8*>(a + 32 * 256);
        p0 = __builtin_amdgcn_mfma_f32_32x32x16_bf16(b0, qr[d0], p0, 0, 0, 0);
        p1 = __builtin_amdgcn_mfma_f32_32x32x16_bf16(b1, qr[d0], p1, 0, 0, 0); }
}
template <int VB>
__device__ __forceinline__ void pv_tile(f32x16* o, int vb0, bf16x8 pa0, bf16x8 pa1, bf16x8 pa2, bf16x8 pa3) {
#define TRRD(dst, off) asm volatile("ds_read_b64_tr_b16 %0, %1 offset:%2" : "=&v"(dst) : "v"(vb0), "i"(off) : "memory")
#define PV_D0(d0) do { s16x4 l0, l1, l2, l3, h0, h1, h2, h3; constexpr int b_ = VB * SHM_V + v_rd_off(d0, 0, 0); \
        TRRD(l0, b_); TRRD(h0, b_ + 2048); TRRD(l1, b_ + 4096); TRRD(h1, b_ + 6144); TRRD(l2, b_ + 8192); TRRD(h2, b_ + 10240); TRRD(l3, b_ + 12288); TRRD(h3, b_ + 14336); \
        asm volatile("s_waitcnt lgkmcnt(0)" ::: "memory"); SBAR();   \
        o[d0] = __builtin_amdgcn_mfma_f32_32x32x16_bf16(pa0, (bf16x8){l0[0], l0[1], l0[2], l0[3], h0[0], h0[1], h0[2], h0[3]}, o[d0], 0, 0, 0);   \
        o[d0] = __builtin_amdgcn_mfma_f32_32x32x16_bf16(pa1, (bf16x8){l1[0], l1[1], l1[2], l1[3], h1[0], h1[1], h1[2], h1[3]}, o[d0], 0, 0, 0);   \
        o[d0] = __builtin_amdgcn_mfma_f32_32x32x16_bf16(pa2, (bf16x8){l2[0], l2[1], l2[2], l2[3], h2[0], h2[1], h2[2], h2[3]}, o[d0], 0, 0, 0);   \
        o[d0] = __builtin_amdgcn_mfma_f32_32x32x16_bf16(pa3, (bf16x8){l3[0], l3[1], l3[2], l3[3], h3[0], h3[1], h3[2], h3[3]}, o[d0], 0, 0, 0); } while (0)
    PV_D0(0); PV_D0(1); PV_D0(2); PV_D0(3);
#undef PV_D0
#undef TRRD
}

struct BlockRef { const bf16_t* Q; const bf16_t* K; int P0; int row0; int h; };
struct Seam { bf16x8 qr[8]; bf16x8 st_v0, st_v1, st_k0, st_k1; };
constexpr size_t VDELTA = (WS_V - WS_K) / 2;
__device__ __forceinline__ bf16x8 load8o(const bf16_t* base, unsigned byteoff) { return *reinterpret_cast<const bf16x8*>((const char*)base + byteoff); }
#define ROWB(k0, rr) (rowoff + (unsigned)(((k0) + (rr)) * D * 2))
#define VMW() asm volatile("s_waitcnt vmcnt(0)" ::: "memory")
#define VMWN(n) asm volatile("s_waitcnt vmcnt(%0)" :: "i"(n) : "memory")
#define SLOAD_H(Kp, k0) do { S.st_v0 = load8o((Kp) + VDELTA, ROWB(k0, 0)); S.st_v1 = load8o((Kp) + VDELTA, ROWB(k0, 32));              \
                         S.st_k0 = load8o(Kp, ROWB(k0, 0)); S.st_k1 = load8o(Kp, ROWB(k0, 32)); } while (0)
#define SWRITE_HK(bf) do { *(bf16x8*)(K_lds + (bf) * SHM_K + kws) = S.st_k0; *(bf16x8*)(K_lds + (bf) * SHM_K + kws + 32 * 256) = S.st_k1; } while (0)
#define SWRITE_HV(bf) do { *(bf16x8*)(V_lds + (bf) * SHM_V + vst0) = S.st_v0; *(bf16x8*)(V_lds + (bf) * SHM_V + vst1) = S.st_v1; } while (0)
#define SWRITE_H(bf) do { SWRITE_HV(bf); SWRITE_HK(bf); } while (0)
__device__ __forceinline__ void prime(const BlockRef& cur, char* lds, Seam& S) {
    const int tid = threadIdx.x, wid = __builtin_amdgcn_readfirstlane(tid >> 6), lane = tid & 63, r32 = lane & 31, hi = lane >> 5;
    const int sr = tid >> 4, sc = (tid & 15) * 8, kws = KSWZ(sr, sc * 2); char* K_lds = lds + 2 * SHM_V;
    const unsigned rowoff = (unsigned)(sr * D + sc) * 2u, qoff = (unsigned)((wid * QBLK + r32) * D + hi * 8) * 2u;
#pragma unroll
    for (int d0 = 0; d0 < 8; ++d0) S.qr[d0] = load8o(cur.Q, qoff + d0 * 32);
    SLOAD_H(cur.K, 0); VMW(); SWRITE_HK(0);
    __syncthreads();
}
__device__ __forceinline__ void block(const BlockRef& cur, const BlockRef& nxt, char* lds, Seam& S, const bf16_t* __restrict__ Zg, bf16_t* __restrict__ G) {
    const int tid = threadIdx.x, wid = __builtin_amdgcn_readfirstlane(tid >> 6), lane = tid & 63, r32 = lane & 31, hi = lane >> 5;
    const int NT = (cur.P0 + QB - 1) / KVBLK + 1;
    const int qlo = cur.P0 + wid * QBLK, qm = qlo + r32 - 4 * hi;
    char* V_lds = lds; char* K_lds = lds + 2 * SHM_V;
    float* ws = (float*)(lds + OFF_WS) + wid * 64; float* li_l = ws; float* al_l = ws + 32;
    const float* nbk = (const float*)(lds + OFF_NBK);
    float m_reg = -1e30f, l_reg = 0; f32x16 o[4] = {};
    const int sr = tid >> 4, sc = (tid & 15) * 8, vst0 = v_st(sr, sc), vst1 = v_st(32 + sr, sc), kws = KSWZ(sr, sc * 2);
    const int vb0 = (int)(uintptr_t)V_lds + v_rd_base(lane);
    const bf16_t* Kh = cur.K;
    const unsigned rowoff = (unsigned)(sr * D + sc) * 2u, qoff = (unsigned)((wid * QBLK + r32) * D + hi * 8) * 2u;
#define RESC(a) do { if (__any((a) < 1.f)) { if (hi == 0) al_l[r32] = (a); asm volatile("s_waitcnt lgkmcnt(0)" ::: "memory");              \
                     _Pragma("unroll") for (int d_ = 0; d_ < 4; ++d_) _Pragma("unroll") for (int r = 0; r < 16; ++r) o[d_][r] *= al_l[crow(r, hi)]; } } while (0)
#define KBASE(t) ((t) * KVBLK)
#define MASKT(P0_, P1_, t) do { const int kb_ = KBASE(t); if (kb_ + KVBLK - 1 > qlo) mask_tile(P0_, P1_, qm - kb_); } while (0)
#define SEAM_K0() do { VMWN(8); SWRITE_HK(0); SBAR(); } while (0)
    f32x16 pA0, pA1, pB0, pB1; float mnA, mnB, alA, alB; bf16x8 pa0, pa1, pa2, pa3;
    SWRITE_HV(0); SBAR();
    if (NT > 1) SLOAD_H(Kh, KBASE(1));
    u32x4 kd[8];
    { const unsigned koff = (unsigned)((cur.P0 + wid * QBLK + r32) * D + hi * 8) * 2u;
#pragma unroll
      for (int d0 = 0; d0 < 8; ++d0) kd[d0] = *reinterpret_cast<const u32x4*>((const char*)Kh + koff + d0 * 32); }
    SBAR(); qkt<0>(pA0, pA1, K_lds, nbk, r32, hi, S.qr);
    { float ds = 0.f;
#pragma unroll
      for (int d0 = 0; d0 < 8; ++d0) { const u32x4 qq = *reinterpret_cast<const u32x4*>(&S.qr[d0]); const u32x4 kk = kd[d0];
          ds += bflo(qq.x) * bflo(kk.x) + bfhi(qq.x) * bfhi(kk.x) + bflo(qq.y) * bflo(kk.y) + bfhi(qq.y) * bfhi(kk.y)
              + bflo(qq.z) * bflo(kk.z) + bfhi(qq.z) * bfhi(kk.z) + bflo(qq.w) * bflo(kk.w) + bfhi(qq.w) * bfhi(kk.w); }
      auto rr = __builtin_amdgcn_permlane32_swap(__float_as_uint(ds), __float_as_uint(ds), false, false);
      m_reg = __uint_as_float(rr[0]) + __uint_as_float(rr[1]) + nbk[cur.P0 + wid * QBLK + r32]; }
    MASKT(pA0, pA1, 0); partialSM(pA0, pA1, m_reg, mnA, alA);
    if (NT > 1) { VMW(); SWRITE_H(1); }
    __syncthreads();
#define HALF_STEP(PX0, PX1, mnX, alX, PY0, PY1, alY, t, KB, VB, SB) do {                                                      \
        SBAR(); qkt<KB>(PX0, PX1, K_lds, nbk + (t) * KVBLK, r32, hi, S.qr);                                                   \
        finishSM(PY0, PY1, alY, l_reg, pa0, pa1, pa2, pa3); SBAR();                                                           \
        if ((t) + 1 < NT) { SLOAD_H(Kh, KBASE((t) + 1)); SBAR(); }                                                        \
        pv_tile<VB>(o, vb0, pa0, pa1, pa2, pa3); MASKT(PX0, PX1, (t)); partialSM(PX0, PX1, m_reg, mnX, alX);                  \
        __syncthreads();                                                                                                      \
        if ((t) + 1 < NT) { VMW(); SWRITE_H(SB); }                                                                            \
        RESC(alX); __syncthreads(); } while (0)
    for (int t = 1; t + 1 < NT; t += 2) {
        HALF_STEP(pB0, pB1, mnB, alB, pA0, pA1, alA, t, 1, 0, 0);
        HALF_STEP(pA0, pA1, mnA, alA, pB0, pB1, alB, t + 1, 0, 1, 1);
    }
    SLOAD_H(nxt.K, 0); SBAR();
#pragma unroll
    for (int d0 = 0; d0 < 8; ++d0) S.qr[d0] = load8o(nxt.Q, qoff + d0 * 32);
    SBAR();
    finishSM(pA0, pA1, alA, l_reg, pa0, pa1, pa2, pa3); SBAR();
    pv_tile<0>(o, vb0, pa0, pa1, pa2, pa3);
    SBAR(); SEAM_K0();
    if (hi == 0) li_l[r32] = l_reg; asm volatile("s_waitcnt lgkmcnt(0)" ::: "memory");
    {
        float* stgA = (float*)(lds + (wid < 4 ? SHM_V + wid * 4096 : 2 * SHM_V + SHM_K + (wid - 4) * 4096));
        float* stgB = (float*)(lds + ATT_LDS + wid * 4096);
        const bf16_t* zp = Zg + (size_t)(cur.row0 + wid * QBLK) * DM + cur.h * HD + (size_t)(lane >> 4) * DM + (lane & 15) * 8;
        bf16_t* gp = G + (size_t)(cur.row0 + wid * QBLK) * DM + cur.h * HD + (size_t)(lane >> 4) * DM + (lane & 15) * 8;
        u32x4 zv[2][4];
#pragma unroll
        for (int p = 0; p < 2; ++p)
#pragma unroll
            for (int k = 0; k < 4; ++k) zv[p][k] = *(const u32x4*)(zp + (size_t)(16 * p + 4 * k) * DM);
        float rli[16];
#pragma unroll
        for (int r = 0; r < 16; ++r) rli[r] = __builtin_amdgcn_rcpf(li_l[crow(r, hi)]);
#pragma unroll
        for (int p = 0; p < 2; ++p) {
#pragma unroll
            for (int rr = 0; rr < 8; ++rr) { const int r = 8 * p + rr; float* dst = ((rr >> 2) ? stgB : stgA) + ((rr & 3) + 4 * hi) * 128 + r32;
#pragma unroll
                for (int d0 = 0; d0 < 4; ++d0) dst[d0 * 32] = o[d0][r] * rli[r]; }
            asm volatile("s_waitcnt lgkmcnt(0)" ::: "memory");
#pragma unroll
            for (int k = 0; k < 4; ++k) { const float* src = ((k >> 1) ? stgB : stgA) + (((k & 1) * 4 + (lane >> 4)) * 128 + (lane & 15) * 8);
                const f32x4 a0 = *(const f32x4*)src, a1 = *(const f32x4*)(src + 4); const u32x4 zw = zv[p][k];
                u32x4 w;
                w.x = cvt_pk_bf16(a0[0] * silu_f(bflo(zw.x)), a0[1] * silu_f(bfhi(zw.x))); w.y = cvt_pk_bf16(a0[2] * silu_f(bflo(zw.y)), a0[3] * silu_f(bfhi(zw.y)));
                w.z = cvt_pk_bf16(a1[0] * silu_f(bflo(zw.z)), a1[1] * silu_f(bfhi(zw.z))); w.w = cvt_pk_bf16(a1[2] * silu_f(bflo(zw.w)), a1[3] * silu_f(bfhi(zw.w)));
                *(u32x4*)(gp + (size_t)(16 * p + 4 * k) * DM) = w; }
            asm volatile("s_waitcnt lgkmcnt(0)" ::: "memory");
        }
    }
    __syncthreads();
#undef RESC
#undef KBASE
#undef MASKT
#undef SEAM_K0
#undef HALF_STEP
}
#undef ROWB
#undef VMWN
#undef SLOAD_H
#undef SWRITE_HK
#undef SWRITE_HV
#undef SWRITE_H

__device__ __forceinline__ void load_nbk(const float* __restrict__ lf, char* lds) {
    float* nbk = (float*)(lds + OFF_NBK); float* scr = (float*)(lds + OFF_SCAN);
    const int tid = threadIdx.x, lane = tid & 63, wid = tid >> 6, base = tid * 9;
    float v[9]; float s = 0.f;
#pragma unroll
    for (int j = 0; j < 9; ++j) { const int p = base + j; v[j] = p < LTOT ? lf[p] : 0.f; s += v[j]; }
    float incl = s;
#pragma unroll
    for (int off = 1; off < 64; off <<= 1) { const float t = __shfl_up(incl, off); if (lane >= off) incl += t; }
    if (lane == 63) scr[wid] = incl;
    __syncthreads();
    float wp = 0.f;
#pragma unroll
    for (int w = 0; w < 8; ++w) if (w < wid) wp += scr[w];
    float c = wp + incl - s;
    constexpr float INV = 1.0f / SCALE;
#pragma unroll
    for (int j = 0; j < 9; ++j) { c += v[j]; const int p = base + j; if (p < LTOT) { const int kk = p < NMETA ? p : p + 48; nbk[kk] = -c * INV; } }
    if (tid < 48) nbk[16 + tid] = -1e30f;
    __syncthreads();
}
struct Item { int bh, qb0, qb1; };
__device__ __forceinline__ Item decode(int L) { Item it; const int xcd = L & 7, k = L >> 3; it.bh = (k >> 3) * 8 + xcd; const int x = k & 7; it.qb0 = x; it.qb1 = 15 - x; return it; }
__device__ __forceinline__ BlockRef mkref(const Item& it, int pass, const bf16_t* Q, const bf16_t* K) {
    const int qb = pass ? it.qb1 : it.qb0; BlockRef r;
    r.Q = Q + ((size_t)it.bh * SEQ + (size_t)qb * QB) * D; r.K = K + (size_t)it.bh * SKV * D;
    r.P0 = 64 + qb * QB; r.row0 = (it.bh >> 4) * SEQ + qb * QB; r.h = it.bh & 15; return r;
}
__device__ __forceinline__ void attn_phase(char* lds, const bf16_t* Q, const bf16_t* K, const bf16_t* V, const bf16_t* Zg, bf16_t* G, const float* logf) {
    const int total = 512, stride = gridDim.x;
    int L = blockIdx.x; if (L >= total) return;
    Item it = decode(L); int pass = 0;
    BlockRef cur = mkref(it, 0, Q, K);
    load_nbk(logf + (size_t)it.bh * LTOT, lds);
    Seam S;
    prime(cur, lds, S);
    for (;;) {
        const bool more_pass = pass == 0, more_item = L + stride < total, last = !more_pass && !more_item;
        Item itn = it; int passn = pass + 1, Ln = L;
        if (!more_pass) { passn = 0; Ln = more_item ? L + stride : L; itn = decode(Ln); }
        const BlockRef nxt = last ? cur : mkref(itn, passn, Q, K);
        block(cur, nxt, lds, S, Zg, G);
        if (last) break;
        if (itn.bh != it.bh) load_nbk(logf + (size_t)itn.bh * LTOT, lds);
        cur = nxt; it = itn; pass = passn; L = Ln;
    }
}
#undef VMW
#undef SBAR
#undef KSWZ
}

__device__ __forceinline__ f32x4 wave_gemm16(const bf16_t* __restrict__ A, int lda, const bf16_t* __restrict__ Bt, int ldb, int K, int lane) {
    const int fr = lane & 15, fq = lane >> 4;
    const bf16_t* ap = A + (size_t)fr * lda + fq * 8; const bf16_t* bp = Bt + (size_t)fr * ldb + fq * 8;
    f32x4 acc = {0.f, 0.f, 0.f, 0.f};
#pragma unroll 8
    for (int k0 = 0; k0 < K; k0 += 32) {
        const bf16x8 a = *(const bf16x8*)(ap + k0), b = *(const bf16x8*)(bp + k0);
        acc = __builtin_amdgcn_mfma_f32_16x16x32_bf16(a, b, acc, 0, 0, 0);
    }
    return acc;
}

#define XB_TMO      128
#define XB_XCNT(j)  (256  + 64 * (j))
#define XB_XSUB(j)  (1280 + 64 * (j))
#define XB_XGEN(j)  (2304 + 64 * (j))
#define XB_TOP      3328
#define XB_TOPGEN   3392
#define XCD_BAR_WORDS 3456
#define XB_SPIN_CAP (1u << 18)
__device__ __forceinline__ unsigned xb_ld(unsigned* p)              { return __hip_atomic_load(p, __ATOMIC_RELAXED, __HIP_MEMORY_SCOPE_AGENT); }
__device__ __forceinline__ unsigned xb_add(unsigned* p, unsigned v) { return __hip_atomic_fetch_add(p, v, __ATOMIC_RELAXED, __HIP_MEMORY_SCOPE_AGENT); }
__device__ __forceinline__ unsigned xb_xcc_id() { return (unsigned)__builtin_amdgcn_s_getreg((3 << 11) | 20) & 0xFu; }
#define XB_SPIN(cond, bar) do { unsigned _sp = 0; while (cond) { __builtin_amdgcn_s_sleep(1); \
    if ((++_sp & 255u) == 0u) { if (xb_ld(&(bar)[XB_TMO])) break; if (_sp > XB_SPIN_CAP) { atomicAdd(&(bar)[XB_TMO], 1u); break; } } } } while (0)
struct XcdBarrier { unsigned* bar; unsigned x; volatile LAS unsigned* st; };
__device__ __forceinline__ XcdBarrier xcd_barrier_post(unsigned* bar, volatile LAS unsigned* st) {
    XcdBarrier b; b.bar = bar; b.x = xb_xcc_id(); b.st = st;
    if (threadIdx.x == 0) (void)xb_add(&bar[XB_XCNT(b.x)], 1u);
    return b;
}
__device__ __forceinline__ void xcd_barrier_complete(unsigned* bar, unsigned x, unsigned& nloc, unsigned& nx) {
    const unsigned G = gridDim.x * gridDim.y * gridDim.z;
    unsigned sum, cnt, mine, sp = 0u;
    for (;;) {
        sum = 0u; cnt = 0u; mine = 0u;
#pragma unroll
        for (unsigned j = 0; j < 16; ++j) { const unsigned c = xb_ld(&bar[XB_XCNT(j)]); sum += c; cnt += (c > 0u) ? 1u : 0u; mine = (j == x) ? c : mine; }
        if (sum == G) break;
        __builtin_amdgcn_s_sleep(1);
        if ((++sp & 255u) == 0u) { if (xb_ld(&bar[XB_TMO])) break; if (sp > XB_SPIN_CAP) { atomicAdd(&bar[XB_TMO], 1u); break; } }
    }
    nloc = mine > 0u ? mine : 1u; nx = cnt > 0u ? cnt : 1u;
}
__device__ __forceinline__ void xcd_barrier(const XcdBarrier& b) {
    asm volatile("s_waitcnt vmcnt(0)" ::: "memory");
    __syncthreads();
    if (threadIdx.x == 0) {
        unsigned* bar = b.bar;
        __builtin_amdgcn_s_waitcnt(0);
        unsigned nloc = b.st[0], nx = b.st[1];
        if (nloc == 0u) { xcd_barrier_complete(bar, b.x, nloc, nx); b.st[0] = nloc; b.st[1] = nx; }
        const unsigned old = xb_add(&bar[XB_XSUB(b.x)], 1u);
        const unsigned gen = old / nloc;
        if (old + 1u == (gen + 1u) * nloc) {
            __builtin_amdgcn_fence(__ATOMIC_RELEASE, "agent");
            asm volatile("s_waitcnt vmcnt(0)" ::: "memory");
            const unsigned og = xb_add(&bar[XB_TOP], 1u);
            const unsigned tg = og / nx;
            if (og + 1u == (tg + 1u) * nx) xb_add(&bar[XB_TOPGEN], 1u);
            else XB_SPIN(xb_ld(&bar[XB_TOPGEN]) == tg, bar);
            __builtin_amdgcn_fence(__ATOMIC_ACQUIRE, "agent");
            xb_add(&bar[XB_XGEN(b.x)], 1u);
            asm volatile("s_waitcnt vmcnt(0)" ::: "memory");
        } else {
            XB_SPIN(xb_ld(&bar[XB_XGEN(b.x)]) == gen, bar);
            __builtin_amdgcn_fence(__ATOMIC_ACQUIRE, "agent");
            asm volatile("s_waitcnt vmcnt(0)" ::: "memory");
        }
    }
    __syncthreads();
}

struct Args {
    const float* x; const float* meta; const float* w_in; const float* b_f; const float* w_out; const float* ln0_g; const float* ln0_b;
    const float* pw_in; const float* pw_grp; const float* p_scale; const float* pw_out; const float* ln1_g; const float* ln1_b;
    float* out; unsigned char* ws; int ph_lo, ph_hi;
};
constexpr int N_PHASES = 10;

__device__ __forceinline__ void p0_transpose_item(const float* __restrict__ W, int K, int ldw, int nblk, bf16_t* __restrict__ WT, LAS float* scr, int item, int lane) {
    const int kb = item / nblk, nb = item % nblk, k0 = 64 * kb, n0 = 32 * nb;
#pragma unroll 8
    for (int i = 0; i < 32; ++i) { const int kk = 2 * i + (lane >> 5); scr[kk * 33 + (lane & 31)] = W[(size_t)(k0 + kk) * ldw + n0 + (lane & 31)]; }
    LDS_WAIT(); asm volatile("" ::: "memory");
    const int c = lane & 7;
#pragma unroll
    for (int j = 0; j < 4; ++j) { const int n = (lane >> 3) + 8 * j; const LAS float* s = scr + (8 * c) * 33 + n;
        u32x4 o; o.x = cvt_pk_bf16(s[0 * 33], s[1 * 33]); o.y = cvt_pk_bf16(s[2 * 33], s[3 * 33]); o.z = cvt_pk_bf16(s[4 * 33], s[5 * 33]); o.w = cvt_pk_bf16(s[6 * 33], s[7 * 33]);
        *(u32x4*)(WT + (size_t)(n0 + n) * K + k0 + 8 * c) = o; }
    LDS_WAIT(); asm volatile("" ::: "memory");
}
__device__ __forceinline__ void row_to_bf16(const float* __restrict__ xrow, bf16_t* __restrict__ orow, int lane) {
    const f32x4* xr = (const f32x4*)xrow + lane; u32x2* o8 = (u32x2*)orow + lane;
    f32x4 v[8];
#pragma unroll
    for (int j = 0; j < 8; ++j) v[j] = xr[64 * j];
#pragma unroll
    for (int j = 0; j < 8; ++j) { u32x2 w; w.x = cvt_pk_bf16(v[j][0], v[j][1]); w.y = cvt_pk_bf16(v[j][2], v[j][3]); o8[64 * j] = w; }
}
__device__ __forceinline__ void ln_row(const float* __restrict__ trow, const float* __restrict__ g, const float* __restrict__ bb, bf16_t* ob, float* of, float* st, int lane) {
    const f32x4* xr = (const f32x4*)trow + lane;
    f32x4 v[8]; float s = 0.f;
#pragma unroll
    for (int j = 0; j < 8; ++j) { v[j] = xr[64 * j]; s += (v[j][0] + v[j][1]) + (v[j][2] + v[j][3]); }
    const float mean = wave_sum(s) * (1.f / DM); float s2 = 0.f;
#pragma unroll
    for (int j = 0; j < 8; ++j) { const f32x4 d = v[j] - mean; s2 += (d[0] * d[0] + d[1] * d[1]) + (d[2] * d[2] + d[3] * d[3]); }
    const float rstd = 1.0f / sqrtf(wave_sum(s2) * (1.f / DM) + LN_EPS);
    if (st && lane == 0) { st[0] = mean; st[1] = rstd; }
#pragma unroll
    for (int j = 0; j < 8; ++j) {
        const f32x4 gv = ((const f32x4*)g)[lane + 64 * j], bv = ((const f32x4*)bb)[lane + 64 * j];
        const f32x4 y = (v[j] - mean) * rstd * gv + bv;
        if (of) ((f32x4*)of)[lane + 64 * j] = y;
        if (ob) { u32x2 w; w.x = cvt_pk_bf16(y[0], y[1]); w.y = cvt_pk_bf16(y[2], y[3]); ((u32x2*)ob)[lane + 64 * j] = w; }
    }
}

__global__ void __launch_bounds__(512, 2) fwd(Args a) {
    extern __shared__ __attribute__((aligned(16))) unsigned char lds[];
    const int tid = threadIdx.x, lane = tid & 63, wid = __builtin_amdgcn_readfirstlane(tid >> 6);
    const int G = gridDim.x, bx = blockIdx.x;
    const int gw = bx * 8 + wid, NGW = G * 8;
    unsigned char* ws = a.ws;
    float* LOGF = (float*)(ws + WS_LOGF); bf16_t* MB = (bf16_t*)(ws + WS_MB); float* PM = (float*)(ws + WS_PM); bf16_t* GM = (bf16_t*)(ws + WS_GM);
    float* T0M = (float*)(ws + WS_T0M); bf16_t* H1MB = (bf16_t*)(ws + WS_H1MB); float* UM = (float*)(ws + WS_UM); float* STATS = (float*)(ws + WS_STATS);
    bf16_t* W1T = (bf16_t*)(ws + WS_W1T); bf16_t* WOT = (bf16_t*)(ws + WS_WOT); bf16_t* WPT = (bf16_t*)(ws + WS_WPT); bf16_t* WGT = (bf16_t*)(ws + WS_WGT); bf16_t* WO2T = (bf16_t*)(ws + WS_WO2T);
    bf16_t* H0B = (bf16_t*)(ws + WS_H0B); bf16_t* GB = H0B; bf16_t* EB = H0B;
    bf16_t* QB_ = (bf16_t*)(ws + WS_Q); bf16_t* H1B = QB_;
    bf16_t* KB_ = (bf16_t*)(ws + WS_K); bf16_t* UB = KB_;
    bf16_t* VB_ = (bf16_t*)(ws + WS_V); bf16_t* Z1B = VB_;
    bf16_t* ZB = (bf16_t*)(ws + WS_Z); bf16_t* DPB = ZB;
    const int lo = a.ph_lo, hi = a.ph_hi;
    volatile LAS unsigned* bst = (volatile LAS unsigned*)((LAS unsigned char*)lds + 131072);
    if (tid < 2) bst[tid] = 0u;
    __syncthreads();
    unsigned* BARW = (unsigned*)ws;
    XcdBarrier bar; bar.bar = BARW; bar.x = 0; bar.st = bst;
    if (hi - lo > 1) bar = xcd_barrier_post(BARW, bst);
    if (hi > N_PHASES) cg::this_grid().sync();
#ifdef ONLY_PHASE
#define IN(k) ((k) == ONLY_PHASE && lo <= (k) && (k) < hi)
#else
#define IN(k) (lo <= (k) && (k) < hi)
#endif
#define SEAM(k) do { if (IN(k) && IN((k) + 1)) xcd_barrier(bar); } while (0)

    if (IN(0)) {
        LAS float* scr = (LAS float*)((LAS unsigned char*)lds + wid * 8448);
        constexpr int I1 = 32 * 256, IO = 32 * 64, IP = 32 * 128, IG1 = 8 * 16, IO2 = 32 * 64;
        constexpr int NITEMS = I1 + IO + IP + 4 * IG1 + IO2;
        for (int it = gw; it < NITEMS; it += NGW) {
            int r = it;
            if (r < I1) { p0_transpose_item(a.w_in, DM, N1F, 256, W1T, scr, r, lane); continue; } r -= I1;
            if (r < IO) { p0_transpose_item(a.w_out, DM, DM, 64, WOT, scr, r, lane); continue; } r -= IO;
            if (r < IP) { p0_transpose_item(a.pw_in, DM, 2 * DM, 128, WPT, scr, r, lane); continue; } r -= IP;
            if (r < 4 * IG1) { const int gq = r / IG1; p0_transpose_item(a.pw_grp + (size_t)gq * 512 * 512, 512, 512, 16, WGT + (size_t)gq * 512 * 512, scr, r % IG1, lane); continue; } r -= 4 * IG1;
            p0_transpose_item(a.pw_out, DM, DM, 64, WO2T, scr, r, lane);
        }
        for (int e = bx * 512 + tid; e < 16 * DM; e += G * 512) { const int k = e >> 4, n = e & 15; const float w = a.w_in[(size_t)k * N1F + N1 + n];
            W1T[(size_t)(N1 + n) * DM + k] = (bf16_t)(cvt_pk_bf16(w, 0.f) & 0xffffu); }
        for (int m = gw; m < M; m += NGW) row_to_bf16(a.x + (size_t)m * DM, H0B + (size_t)m * DM, lane);
        for (int m = gw; m < NMETA; m += NGW) row_to_bf16(a.meta + (size_t)m * DM, MB + (size_t)m * DM, lane);
        for (int e = bx * 512 + tid; e < NB * NH * 768 * 2; e += G * 512) { const int kv = e & 1, r = e >> 1, bh = r / 768, c = r % 768;
            u32x4 z = {0u, 0u, 0u, 0u}; *(u32x4*)((kv ? VB_ : KB_) + ((size_t)bh * SKV + 16) * HD + (size_t)c * 8) = z; }
    }
    SEAM(0);

    if (IN(1)) {
        const int fr = lane & 15, fq = lane >> 4;
        for (int t = gw; t < 513 + 1024; t += NGW) {
            if (t < 513) {
                const f32x4 acc = wave_gemm16(MB, DM, W1T + (size_t)t * 16 * DM, DM, DM, lane);
                const int n = t * 16 + fr;
#pragma unroll
                for (int i = 0; i < 4; ++i) {
                    const int r = 4 * fq + i; PM[(size_t)r * N1F + n] = acc[i];
                    if (n >= 2048 && n < 6144) { const int kv = n >= 4096, cc = n - (kv ? 4096 : 2048), h = cc >> 7, d = cc & 127; const bf16_t v = (bf16_t)(cvt_pk_bf16(acc[i], 0.f) & 0xffffu);
#pragma unroll
                        for (int b = 0; b < NB; ++b) (kv ? VB_ : KB_)[((size_t)(b * NH + h) * SKV + r) * HD + d] = v; }
                    if (n >= N1) { const float lf = logsig_f(acc[i] + a.b_f[fr]);
#pragma unroll
                        for (int b = 0; b < NB; ++b) LOGF[(size_t)(b * NH + fr) * LTOT + r] = lf; }
                }
            } else {
                const int t2 = t - 513;
                const f32x4 acc = wave_gemm16(H0B + (size_t)t2 * 16 * DM, DM, W1T + (size_t)N1 * DM, DM, DM, lane);
                const float bf = a.b_f[fr];
#pragma unroll
                for (int i = 0; i < 4; ++i) { const int row = t2 * 16 + 4 * fq + i, b = row >> 12, ii = row & 4095;
                    LOGF[(size_t)(b * NH + fr) * LTOT + NMETA + ii] = logsig_f(acc[i] + bf); }
            }
        }
        pg8::Gemm g{H0B, W1T, DM, DM, DM, 0}; pg8::StaticOrder S; S.init(M, N1, G, bx);
        pg8::EpiQKVZ E{QB_, KB_, VB_, ZB};
        pg8::gemm_phase<pg8::EpiQKVZ, pg8::StaticOrder, true>((LAS unsigned char*)lds, g, S, E);
    }
    SEAM(1);

    if (IN(2)) {
        for (int task = gw; task < 256; task += NGW) {
            const int h = task >> 4, i = task & 15; const float bf = a.b_f[h];
            const float q0 = PM[(size_t)i * N1F + h * HD + 2 * lane], q1 = PM[(size_t)i * N1F + h * HD + 2 * lane + 1];
            float ci = 0.f; for (int p = 0; p <= i; ++p) ci += logsig_f(PM[(size_t)p * N1F + N1 + h] + bf);
            float cj = 0.f, mx = -1e30f, l = 0.f, o0 = 0.f, o1 = 0.f;
            for (int j = 0; j <= i; ++j) {
                cj += logsig_f(PM[(size_t)j * N1F + N1 + h] + bf);
                const float k0 = PM[(size_t)j * N1F + 2048 + h * HD + 2 * lane], k1 = PM[(size_t)j * N1F + 2048 + h * HD + 2 * lane + 1];
                const float s = wave_sum(q0 * k0 + q1 * k1) * ATT_SCALE + ci - cj;
                const float mn = fmaxf(mx, s), al = __expf(mx - mn), p = __expf(s - mn);
                const float v0 = PM[(size_t)j * N1F + 4096 + h * HD + 2 * lane], v1 = PM[(size_t)j * N1F + 4096 + h * HD + 2 * lane + 1];
                l = l * al + p; o0 = o0 * al + p * v0; o1 = o1 * al + p * v1; mx = mn;
            }
            const float z0 = PM[(size_t)i * N1F + 6144 + h * HD + 2 * lane], z1 = PM[(size_t)i * N1F + 6144 + h * HD + 2 * lane + 1];
            const float rl = 1.0f / l;
            *(unsigned*)(GM + (size_t)i * DM + h * HD + 2 * lane) = cvt_pk_bf16(o0 * rl * silu_f(z0), o1 * rl * silu_f(z1));
        }
        att::attn_phase((char*)lds, QB_, KB_, VB_, ZB, GB, LOGF);
    }
    SEAM(2);

    if (IN(3)) {
        const int fr = lane & 15, fq = lane >> 4;
        for (int t = gw; t < 128; t += NGW) {
            const f32x4 acc = wave_gemm16(GM, DM, WOT + (size_t)t * 16 * DM, DM, DM, lane);
#pragma unroll
            for (int i = 0; i < 4; ++i) { const int r = 4 * fq + i, n = t * 16 + fr; T0M[(size_t)r * DM + n] = ALPHA * a.meta[(size_t)r * DM + n] + acc[i]; }
        }
        pg8::Gemm g{GB, WOT, DM, DM, DM, 0}; pg8::StaticOrder S; S.init(M, DM, G, bx);
        pg8::EpiT0 E{a.x, a.out};
        pg8::gemm_phase<pg8::EpiT0, pg8::StaticOrder, true>((LAS unsigned char*)lds, g, S, E);
    }
    SEAM(3);

    if (IN(4)) {
        for (int m = gw; m < M + NMETA; m += NGW) {
            if (m < M) ln_row(a.out + (size_t)m * DM, a.ln0_g, a.ln0_b, H1B + (size_t)m * DM, nullptr, STATS + 2 * (size_t)m, lane);
            else ln_row(T0M + (size_t)(m - M) * DM, a.ln0_g, a.ln0_b, H1MB + (size_t)(m - M) * DM, nullptr, nullptr, lane);
        }
    }
    SEAM(4);

    if (IN(5)) {
        const int fr = lane & 15, fq = lane >> 4;
        for (int t = gw; t < 128; t += NGW) {
            const f32x4 acc = wave_gemm16(H1MB, DM, WPT + (size_t)t * 16 * DM, DM, DM, lane);
#pragma unroll
            for (int i = 0; i < 4; ++i) UM[(size_t)(4 * fq + i) * DM + t * 16 + fr] = acc[i];
        }
        pg8::Gemm g{H1B, WPT, DM, DM, DM, 0}; pg8::StaticOrder S; S.init(M, 2 * DM, G, bx);
        pg8::EpiSplit2 E{UB, Z1B};
        pg8::gemm_phase<pg8::EpiSplit2, pg8::StaticOrder, true>((LAS unsigned char*)lds, g, S, E);
    }
    SEAM(5);

    if (IN(6)) {
        for (int it = bx * 512 + tid; it < (M / 32) * 256; it += G * 512) {
            const int chunk = it & 255, run = it >> 8, c0 = chunk * 8, gq = c0 >> 9, w = 2 << gq; const float invw = 1.0f / (float)w;
            const int row0 = run * 32, b = row0 >> 12, i0 = row0 & 4095;
            const bf16_t* Ub = UB + (size_t)(b * SEQ) * DM + c0; const float* Um = UM + c0;
            float sum[8];
#pragma unroll
            for (int e = 0; e < 8; ++e) sum[e] = 0.f;
            for (int j = 1; j < w; ++j) { const int i = i0 - j;
                if (i >= 0) { const u32x4 q = *(const u32x4*)(Ub + (size_t)i * DM);
                    sum[0] += bflo(q.x); sum[1] += bfhi(q.x); sum[2] += bflo(q.y); sum[3] += bfhi(q.y); sum[4] += bflo(q.z); sum[5] += bfhi(q.z); sum[6] += bflo(q.w); sum[7] += bfhi(q.w); }
                else { const f32x4 p0 = *(const f32x4*)(Um + (size_t)(16 + i) * DM), p1 = *(const f32x4*)(Um + (size_t)(16 + i) * DM + 4);
                    sum[0] += p0[0]; sum[1] += p0[1]; sum[2] += p0[2]; sum[3] += p0[3]; sum[4] += p1[0]; sum[5] += p1[1]; sum[6] += p1[2]; sum[7] += p1[3]; } }
#pragma unroll 4
            for (int s = 0; s < 32; ++s) { const int i = i0 + s;
                const u32x4 q = *(const u32x4*)(Ub + (size_t)i * DM);
                float f[8] = {bflo(q.x), bfhi(q.x), bflo(q.y), bfhi(q.y), bflo(q.z), bfhi(q.z), bflo(q.w), bfhi(q.w)};
                float d[8];
#pragma unroll
                for (int e = 0; e < 8; ++e) { sum[e] += f[e]; d[e] = sum[e] * invw - f[e]; }
                u32x4 o; o.x = cvt_pk_bf16(d[0], d[1]); o.y = cvt_pk_bf16(d[2], d[3]); o.z = cvt_pk_bf16(d[4], d[5]); o.w = cvt_pk_bf16(d[6], d[7]);
                *(u32x4*)(DPB + (size_t)(row0 + s) * DM + c0) = o;
                const int io = i - w + 1;
                if (io >= 0) { const u32x4 r = *(const u32x4*)(Ub + (size_t)io * DM);
                    sum[0] -= bflo(r.x); sum[1] -= bfhi(r.x); sum[2] -= bflo(r.y); sum[3] -= bfhi(r.y); sum[4] -= bflo(r.z); sum[5] -= bfhi(r.z); sum[6] -= bflo(r.w); sum[7] -= bfhi(r.w); }
                else { const f32x4 p0 = *(const f32x4*)(Um + (size_t)(16 + io) * DM), p1 = *(const f32x4*)(Um + (size_t)(16 + io) * DM + 4);
                    sum[0] -= p0[0]; sum[1] -= p0[1]; sum[2] -= p0[2]; sum[3] -= p0[3]; sum[4] -= p1[0]; sum[5] -= p1[1]; sum[6] -= p1[2]; sum[7] -= p1[3]; } }
        }
    }
    SEAM(6);

    if (IN(7)) {
        pg8::Gemm g{DPB, WGT, DM, 512, 512, 2}; pg8::StaticOrder S; S.init(M, DM, G, bx);
        pg8::EpiGate E{Z1B, a.p_scale, EB};
        pg8::gemm_phase<pg8::EpiGate, pg8::StaticOrder, true>((LAS unsigned char*)lds, g, S, E);
    }
    SEAM(7);

    if (IN(8)) {
        pg8::Gemm g{EB, WO2T, DM, DM, DM, 0}; pg8::StaticOrder S; S.init(M, DM, G, bx);
        pg8::EpiT1 E{a.out, STATS, a.ln0_g, a.ln0_b};
        pg8::gemm_phase<pg8::EpiT1, pg8::StaticOrder, true>((LAS unsigned char*)lds, g, S, E);
    }
    SEAM(8);

    if (IN(9)) {
        for (int m = gw; m < M; m += NGW) ln_row(a.out + (size_t)m * DM, a.ln1_g, a.ln1_b, nullptr, a.out + (size_t)m * DM, nullptr, lane);
    }
#undef IN
#undef SEAM
}

extern "C" void kernel_launch(void* const* d_in, const int* in_sizes, int n_in, void* d_out, int out_size, void* d_ws, size_t ws_size, hipStream_t stream) {
    static int grid = 0;
    if (grid == 0) {
        if (n_in != 13 || in_sizes[0] != M * DM || out_size != M * DM || ws_size < WS_END) { fprintf(stderr, "kernel_launch: shape/workspace mismatch (n_in %d, in0 %d, out %d, ws %zu)\n", n_in, n_in > 0 ? in_sizes[0] : -1, out_size, ws_size); grid = -1; return; }
        int dev = 0, cus = 0, per_cu = 0;
        (void)hipGetDevice(&dev); (void)hipDeviceGetAttribute(&cus, hipDeviceAttributeMultiprocessorCount, dev);
        if (hipFuncSetAttribute((const void*)fwd, hipFuncAttributeMaxDynamicSharedMemorySize, LDS_BYTES) != hipSuccess) { fprintf(stderr, "kernel_launch: hipFuncSetAttribute failed\n"); grid = -1; return; }
        if (hipOccupancyMaxActiveBlocksPerMultiprocessor(&per_cu, (const void*)fwd, 512, LDS_BYTES) != hipSuccess || per_cu < 1) { fprintf(stderr, "kernel_launch: occupancy query says %d\n", per_cu); per_cu = 1; }
        (void)hipGetLastError();
        grid = cus * 1;
        if (grid <= 0) grid = 256;
    }
    if (grid < 0) return;
    Args a{};
    a.x = (const float*)d_in[0]; a.meta = (const float*)d_in[1]; a.w_in = (const float*)d_in[2]; a.b_f = (const float*)d_in[3]; a.w_out = (const float*)d_in[4];
    a.ln0_g = (const float*)d_in[5]; a.ln0_b = (const float*)d_in[6]; a.pw_in = (const float*)d_in[7]; a.pw_grp = (const float*)d_in[8]; a.p_scale = (const float*)d_in[9];
    a.pw_out = (const float*)d_in[10]; a.ln1_g = (const float*)d_in[11]; a.ln1_b = (const float*)d_in[12];
    a.out = (float*)d_out; a.ws = (unsigned char*)d_ws;
#if MK_N_LAUNCHES == 1
    a.ph_lo = 0; a.ph_hi = N_PHASES;
    if (hipMemsetAsync(d_ws, 0, 16384, stream) != hipSuccess) { fprintf(stderr, "kernel_launch: memset of the barrier words failed\n"); return; }
    void* args[] = {&a};
    hipError_t e = hipLaunchCooperativeKernel((const void*)fwd, dim3(grid), dim3(512), args, LDS_BYTES, stream);
    if (e != hipSuccess) fprintf(stderr, "kernel_launch: cooperative launch failed: %s (grid %d)\n", hipGetErrorString(e), grid);
#else
    for (int p = 0; p < N_PHASES; ++p) for (int rep = 0; rep < (p == PROBE_DUP ? 2 : 1); ++rep) { a.ph_lo = p; a.ph_hi = p + 1; hipLaunchKernelGGL(fwd, dim3(grid), dim3(512), LDS_BYTES, stream, a); }
#endif
}
```

```cpp
#include <hip/hip_runtime.h>
#include <hip/hip_cooperative_groups.h>
#include <cstdio>
#include <cstdint>
namespace cg = cooperative_groups;

#ifndef MK_N_LAUNCHES
#define MK_N_LAUNCHES 1
#endif

#ifndef PROBE_DUP
#define PROBE_DUP -1
#endif
#define LAS __attribute__((address_space(3)))
typedef unsigned short bf16_t;
typedef short bf16x8 __attribute__((ext_vector_type(8)));
typedef short s16x4 __attribute__((ext_vector_type(4)));
typedef float f32x4 __attribute__((ext_vector_type(4)));
typedef float f32x2 __attribute__((ext_vector_type(2)));
typedef float f32x16 __attribute__((ext_vector_type(16)));
typedef unsigned u32x4 __attribute__((ext_vector_type(4)));
typedef unsigned u32x2 __attribute__((ext_vector_type(2)));

constexpr int DM = 2048, NB = 4, SEQ = 4096, NMETA = 16, NH = 16, HD = 128;
constexpr int M = NB * SEQ;
constexpr int LTOT = SEQ + NMETA;
constexpr int SKV = SEQ + 64;
constexpr int N1 = 8192, N1F = 8208;
constexpr float ALPHA = 1.4142135623730951f;
constexpr float LN_EPS = 1e-5f;
constexpr float ATT_SCALE = 0.08838834764831845f;

constexpr size_t MiB = 1u << 20;
constexpr size_t WS_LOGF = 1 * MiB;
constexpr size_t WS_MB = 3 * MiB;
constexpr size_t WS_PM = 3 * MiB + 256 * 1024;
constexpr size_t WS_GM = 4 * MiB;
constexpr size_t WS_T0M = 4 * MiB + 64 * 1024;
constexpr size_t WS_H1MB = 4 * MiB + 192 * 1024;
constexpr size_t WS_UM = 4 * MiB + 256 * 1024;
constexpr size_t WS_STATS = 5 * MiB;
constexpr size_t WS_NBKG = 6 * MiB;
constexpr size_t WS_TBG = 7 * MiB + 512 * 1024;
constexpr size_t WS_W1T = 8 * MiB;
constexpr size_t WS_WOT = 41 * MiB;
constexpr size_t WS_WPT = 49 * MiB;
constexpr size_t WS_WGT = 65 * MiB;
constexpr size_t WS_WO2T = 67 * MiB;
constexpr size_t WS_H0B = 76 * MiB;
constexpr size_t WS_Q = 140 * MiB;
constexpr size_t WS_K = 204 * MiB;
constexpr size_t WS_V = 269 * MiB;
constexpr size_t WS_Z = 334 * MiB;
constexpr size_t WS_END = 398 * MiB;

constexpr int LDS_BYTES = 135168;

__device__ __forceinline__ unsigned cvt_pk_bf16(float lo, float hi) { unsigned r; asm volatile("v_cvt_pk_bf16_f32 %0, %1, %2" : "=v"(r) : "v"(lo), "v"(hi)); return r; }
__device__ __forceinline__ float bf2f(unsigned short v) { return __uint_as_float((unsigned)v << 16); }
__device__ __forceinline__ float bflo(unsigned w) { return __uint_as_float(w << 16); }
__device__ __forceinline__ float bfhi(unsigned w) { return __uint_as_float(w & 0xffff0000u); }
__device__ __forceinline__ float silu_f(float z) { return z * __builtin_amdgcn_rcpf(1.0f + __expf(-z)); }
__device__ __forceinline__ float logsig_f(float x) { return fminf(x, 0.f) - log1pf(expf(-fabsf(x))); }
__device__ __forceinline__ float wave_sum(float v) {
#pragma unroll
    for (int o = 1; o < 64; o <<= 1) v += __shfl_xor(v, o);
    return v;
}
#define LDS_WAIT() asm volatile("s_waitcnt lgkmcnt(0)" ::: "memory")

namespace pg8 {
constexpr int BM = 256, BK = 64, HALF = 128, HTB = HALF * BK * 2, STAGE_BYTES = 8 * HTB, NXCD = 8, WGM = 8;
__host__ __device__ __forceinline__ int lds_byte(int r, int c) { const int st = (r >> 4) * 2 + (c >> 5), rr = r & 15, cc = c & 31, ob = rr * 64 + cc * 2; return st * 1024 + (ob ^ (((ob >> 9) & 1) << 5)); }
__host__ __device__ __forceinline__ void stage_rc(int b, int& R, int& C) { const int st = b / 1024, sb = b % 1024, swz = sb ^ (((sb >> 9) & 1) << 5); R = (st >> 1) * 16 + swz / 64; C = (st & 1) * 32 + (swz % 64) / 2; }
__host__ __device__ __forceinline__ int perm32(int rho) { const int n = rho >> 4, i = rho & 15; return 8 * (i >> 2) + 4 * n + (i & 3); }

struct Unit { int pm, pn; };
struct Gemm { const bf16_t* A; const bf16_t* Bt; int lda, ldb, K, grp; };

struct StaticOrder {
    int nM, nN, nwg, G, c;
    __host__ __device__ void init(int M_, int N_, int G_, int c_) { nM = M_ / BM; nN = N_ / BM; nwg = nM * nN; G = G_; c = c_; }
    __host__ __device__ bool next(int i, Unit& u) const {
        const long L = (long)i * G + c; if (L >= nwg) return false;
        int wgid = (int)L; { const int q = nwg / NXCD, r = nwg % NXCD, xcd = wgid % NXCD, off = wgid / NXCD; wgid = (xcd < r ? xcd * (q + 1) : r * (q + 1) + (xcd - r) * q) + off; }
        const int nig = WGM * nN, gid = wgid / nig, fm = gid * WGM, gsz = (nM - fm) < WGM ? (nM - fm) : WGM;
        u.pm = fm + ((wgid % nig) % gsz); u.pn = (wgid % nig) / gsz; return true;
    }
};

template <class Epi, class Sched, bool ALIGN_EPI>
__device__ __forceinline__ void gemm_phase(LAS unsigned char* lds, const Gemm g, const Sched& S, const Epi& E) {
    const int tid = threadIdx.x, wid = __builtin_amdgcn_readfirstlane(tid >> 6), lane = tid & 63, wr = wid >> 2, wc = wid & 3, fr = lane & 15, fq = lane >> 4;
    const int K = g.K, nt = K / BK;
    unsigned voffA[2], voffB[2];
#pragma unroll
    for (int i = 0; i < 2; ++i) { int R, C; stage_rc(tid * 16 + i * 8192, R, C); const int Rb = Epi::PERM ? ((R & ~31) + perm32(R & 31)) : R;
        voffA[i] = (unsigned)(R * g.lda + C) * 2u; voffB[i] = (unsigned)(Rb * g.ldb + C) * 2u; }
    const size_t kstep = (size_t)(BK * 2);
    const size_t hA = (size_t)HALF * g.lda * 2, hB = (size_t)HALF * g.ldb * 2;
    const unsigned ldsw = (unsigned)wid * 1024u;
    const int aoff = lds_byte(wr * 64 + fr, fq * 8), boff = lds_byte(wc * 32 + fr, fq * 8);
#define PG8_SA(b, h) (((b) * 2 + (h)) * HTB)
#define PG8_SB(b, h) ((4 + (b) * 2 + (h)) * HTB)
#define PG8_STAGE(bufoff, gbase, voff) do { _Pragma("unroll") for (int _i = 0; _i < 2; ++_i) \
        __builtin_amdgcn_global_load_lds((const unsigned*)((const char*)(gbase) + (voff)[_i]), (LAS unsigned*)(lds + (bufoff) + ldsw + _i * 8192), 16, 0, 0); } while (0)
#define PG8_LDA(dst, b, h) do { _Pragma("unroll") for (int m = 0; m < 4; ++m) _Pragma("unroll") for (int k = 0; k < 2; ++k) dst[m][k] = *(const LAS bf16x8*)(lds + PG8_SA(b, h) + aoff + m * 2048 + k * 1024); } while (0)
#define PG8_LDB(dst, b, h) do { _Pragma("unroll") for (int n = 0; n < 2; ++n) _Pragma("unroll") for (int k = 0; k < 2; ++k) dst[n][k] = *(const LAS bf16x8*)(lds + PG8_SB(b, h) + boff + n * 2048 + k * 1024); } while (0)
#define PG8_MMA(ai, bj, At, Bt) do { __builtin_amdgcn_s_setprio(1); _Pragma("unroll") for (int m = 0; m < 4; ++m) _Pragma("unroll") for (int n = 0; n < 2; ++n) _Pragma("unroll") for (int k = 0; k < 2; ++k) \
        acc[ai][bj][m][n] = __builtin_amdgcn_mfma_f32_16x16x32_bf16(Bt[n][k], At[m][k], acc[ai][bj][m][n], 0, 0, 0); __builtin_amdgcn_s_setprio(0); } while (0)
#define PG8_WAIT_V(n) asm volatile("s_waitcnt vmcnt(" #n ")" ::: "memory")
#define PG8_WAIT_L(n) asm volatile("s_waitcnt lgkmcnt(" #n ")" ::: "memory")
#define PG8_BAR __builtin_amdgcn_s_barrier()
#define PG8_SCHED __builtin_amdgcn_sched_barrier(0)
#define PG8_UA(u) ((const char*)g.A + (size_t)(u).pm * 2 * hA + (g.grp ? (size_t)((u).pn / g.grp) * (size_t)K * 2 : (size_t)0))
#define PG8_UB(u) ((const char*)g.Bt + (size_t)(u).pn * 2 * hB)
    Unit cur, nxt; int ui = 0;
    if (!S.next(0, cur)) return;
    f32x4 acc[2][2][4][2];
#pragma unroll
    for (int a = 0; a < 2; ++a)
#pragma unroll
        for (int b = 0; b < 2; ++b)
#pragma unroll
            for (int m = 0; m < 4; ++m)
#pragma unroll
                for (int n = 0; n < 2; ++n) acc[a][b][m][n] = (f32x4){0.f, 0.f, 0.f, 0.f};
    bf16x8 At[4][2], B0[2][2], B1[2][2];
    const char* cA = PG8_UA(cur); const char* cB = PG8_UB(cur);
    PG8_STAGE(PG8_SB(0, 0), cB, voffB); PG8_STAGE(PG8_SB(0, 1), cB + hB, voffB); PG8_STAGE(PG8_SA(0, 0), cA, voffA); PG8_STAGE(PG8_SA(0, 1), cA + hA, voffA);
    if (wr == 1) PG8_BAR;
    PG8_WAIT_V(2); PG8_BAR;
    PG8_STAGE(PG8_SB(1, 0), cB + kstep, voffB); PG8_STAGE(PG8_SA(1, 0), cA + kstep, voffA); PG8_STAGE(PG8_SB(1, 1), cB + hB + kstep, voffB);
    PG8_WAIT_V(6); PG8_BAR;
    for (;;) {
        const bool has_next = S.next(ui + 1, nxt);
        const char* nA = has_next ? PG8_UA(nxt) : cA; const char* nB = has_next ? PG8_UB(nxt) : cB;
        for (int t = 0; t < nt; t += 2) {
            const bool last = (t == nt - 2);
            const char* a1 = cA + (size_t)(t + 1) * kstep;
            const char* a2 = last ? nA : cA + (size_t)(t + 2) * kstep; const char* b2 = last ? nB : cB + (size_t)(t + 2) * kstep;
            const char* a3 = a2 + kstep; const char* b3 = b2 + kstep;
            PG8_LDB(B0, 0, 0); PG8_LDB(B1, 0, 1); PG8_SCHED; PG8_LDA(At, 0, 0); PG8_STAGE(PG8_SA(1, 1), a1 + hA, voffA);
            PG8_WAIT_V(8); PG8_WAIT_L(0); PG8_BAR; PG8_MMA(0, 0, At, B0); PG8_MMA(0, 1, At, B1); PG8_BAR; PG8_SCHED;
            PG8_LDA(At, 0, 1); PG8_STAGE(PG8_SB(0, 0), b2, voffB); PG8_STAGE(PG8_SB(0, 1), b2 + hB, voffB); PG8_STAGE(PG8_SA(0, 0), a2, voffA);
            PG8_WAIT_V(8); PG8_WAIT_L(0); PG8_BAR; PG8_MMA(1, 0, At, B0); PG8_MMA(1, 1, At, B1); PG8_BAR; PG8_SCHED;
            PG8_LDB(B0, 1, 0); PG8_LDB(B1, 1, 1); PG8_SCHED; PG8_LDA(At, 1, 0); PG8_STAGE(PG8_SA(0, 1), a2 + hA, voffA);
            PG8_WAIT_V(8); PG8_WAIT_L(0); PG8_BAR; PG8_MMA(0, 0, At, B0); PG8_MMA(0, 1, At, B1); PG8_BAR; PG8_SCHED;
            PG8_LDA(At, 1, 1); PG8_STAGE(PG8_SB(1, 0), b3, voffB); PG8_STAGE(PG8_SB(1, 1), b3 + hB, voffB); PG8_STAGE(PG8_SA(1, 0), a3, voffA);
            PG8_WAIT_V(8); PG8_WAIT_L(0); PG8_BAR; PG8_MMA(1, 0, At, B0); PG8_MMA(1, 1, At, B1); PG8_BAR; PG8_SCHED;
        }
        if constexpr (ALIGN_EPI) { if (wr == 0) PG8_BAR; }
        E(acc, cur, wr, wc, fr, fq);
        if (!has_next) break;
#pragma unroll
        for (int a = 0; a < 2; ++a)
#pragma unroll
            for (int b = 0; b < 2; ++b)
#pragma unroll
                for (int m = 0; m < 4; ++m)
#pragma unroll
                    for (int n = 0; n < 2; ++n) acc[a][b][m][n] = (f32x4){0.f, 0.f, 0.f, 0.f};
        cur = nxt; cA = nA; cB = nB; ++ui;
        if constexpr (ALIGN_EPI) { if (wr == 1) PG8_BAR; }
    }
    PG8_WAIT_V(0);
    if constexpr (!ALIGN_EPI) { if (wr == 0) PG8_BAR; }
    PG8_BAR;
#undef PG8_SA
#undef PG8_SB
#undef PG8_STAGE
#undef PG8_LDA
#undef PG8_LDB
#undef PG8_MMA
#undef PG8_WAIT_V
#undef PG8_WAIT_L
#undef PG8_BAR
#undef PG8_SCHED
#undef PG8_UA
#undef PG8_UB
}

__device__ __forceinline__ u32x4 pack8f(f32x4 a, f32x4 b) { u32x4 w; w.x = cvt_pk_bf16(a[0], a[1]); w.y = cvt_pk_bf16(a[2], a[3]); w.z = cvt_pk_bf16(b[0], b[1]); w.w = cvt_pk_bf16(b[2], b[3]); return w; }

struct EpiQKVZ {
    static constexpr bool PERM = true;
    bf16_t *Q, *Kb, *Vb, *Z;
    __device__ __forceinline__ void operator()(const f32x4 (&acc)[2][2][4][2], const Unit& u, int wr, int wc, int fr, int fq) const {
        const int t = u.pn >> 3, hbase = (u.pn & 7) * 2, d = wc * 32 + 8 * fq;
#pragma unroll
        for (int ai = 0; ai < 2; ++ai)
#pragma unroll
            for (int m = 0; m < 4; ++m) {
                const int row = u.pm * BM + ai * HALF + wr * 64 + m * 16 + fr, b = row >> 12, i = row & 4095;
#pragma unroll
                for (int bj = 0; bj < 2; ++bj) {
                    const int h = hbase + bj; bf16_t* p;
                    if (t == 0) p = Q + ((size_t)((b * NH + h) * SEQ + i)) * HD + d;
                    else if (t == 3) p = Z + (size_t)row * DM + h * HD + d;
                    else p = (t == 1 ? Kb : Vb) + ((size_t)((b * NH + h) * SKV + 64 + i)) * HD + d;
                    *(u32x4*)p = pack8f(acc[ai][bj][m][0], acc[ai][bj][m][1]);
                }
            }
    }
};
struct EpiSplit2 {
    static constexpr bool PERM = true;
    bf16_t *O0, *O1;
    __device__ __forceinline__ void operator()(const f32x4 (&acc)[2][2][4][2], const Unit& u, int wr, int wc, int fr, int fq) const {
        bf16_t* base = (u.pn < 8 ? O0 : O1) + (u.pn & 7) * BM + wc * 32 + 8 * fq;
#pragma unroll
        for (int ai = 0; ai < 2; ++ai)
#pragma unroll
            for (int m = 0; m < 4; ++m) {
                const int row = u.pm * BM + ai * HALF + wr * 64 + m * 16 + fr;
#pragma unroll
                for (int bj = 0; bj < 2; ++bj) *(u32x4*)(base + (size_t)row * DM + bj * HALF) = pack8f(acc[ai][bj][m][0], acc[ai][bj][m][1]);
            }
    }
};
struct EpiT0 {
    static constexpr bool PERM = false;
    const float* X; float* O;
    __device__ __forceinline__ void operator()(const f32x4 (&acc)[2][2][4][2], const Unit& u, int wr, int wc, int fr, int fq) const {
        const int col0 = u.pn * BM + wc * 32 + 4 * fq;
#pragma unroll
        for (int ai = 0; ai < 2; ++ai)
#pragma unroll
            for (int m = 0; m < 4; ++m) {
                const size_t off = (size_t)(u.pm * BM + ai * HALF + wr * 64 + m * 16 + fr) * DM + col0;
#pragma unroll
                for (int bj = 0; bj < 2; ++bj)
#pragma unroll
                    for (int n = 0; n < 2; ++n) { const f32x4 xv = *(const f32x4*)(X + off + bj * HALF + n * 16); *(f32x4*)(O + off + bj * HALF + n * 16) = xv * ALPHA + acc[ai][bj][m][n]; }
            }
    }
};
struct EpiGate {
    static constexpr bool PERM = true;
    const bf16_t* Z1; const float* scale; bf16_t* O;
    __device__ __forceinline__ void operator()(const f32x4 (&acc)[2][2][4][2], const Unit& u, int wr, int wc, int fr, int fq) const {
        const int col0 = u.pn * BM + wc * 32 + 8 * fq;
        f32x4 sv[2][2];
#pragma unroll
        for (int bj = 0; bj < 2; ++bj) { sv[bj][0] = *(const f32x4*)(scale + col0 + bj * HALF); sv[bj][1] = *(const f32x4*)(scale + col0 + bj * HALF + 4); }
#pragma unroll
        for (int ai = 0; ai < 2; ++ai)
#pragma unroll
            for (int m = 0; m < 4; ++m) {
                const size_t off = (size_t)(u.pm * BM + ai * HALF + wr * 64 + m * 16 + fr) * DM + col0;
#pragma unroll
                for (int bj = 0; bj < 2; ++bj) {
                    const u32x4 zw = *(const u32x4*)(Z1 + off + bj * HALF);
                    f32x4 v0 = acc[ai][bj][m][0] * sv[bj][0], v1 = acc[ai][bj][m][1] * sv[bj][1];
                    v0[0] *= silu_f(bflo(zw.x)); v0[1] *= silu_f(bfhi(zw.x)); v0[2] *= silu_f(bflo(zw.y)); v0[3] *= silu_f(bfhi(zw.y));
                    v1[0] *= silu_f(bflo(zw.z)); v1[1] *= silu_f(bfhi(zw.z)); v1[2] *= silu_f(bflo(zw.w)); v1[3] *= silu_f(bfhi(zw.w));
                    *(u32x4*)(O + off + bj * HALF) = pack8f(v0, v1);
                }
            }
    }
};
struct EpiT1 {
    static constexpr bool PERM = false;
    float* T; const float* stats; const float* g; const float* bb;
    __device__ __forceinline__ void operator()(const f32x4 (&acc)[2][2][4][2], const Unit& u, int wr, int wc, int fr, int fq) const {
        const int col0 = u.pn * BM + wc * 32 + 4 * fq;
        f32x4 gv[2][2], bv[2][2];
#pragma unroll
        for (int bj = 0; bj < 2; ++bj)
#pragma unroll
            for (int n = 0; n < 2; ++n) { gv[bj][n] = *(const f32x4*)(g + col0 + bj * HALF + n * 16); bv[bj][n] = *(const f32x4*)(bb + col0 + bj * HALF + n * 16); }
#pragma unroll
        for (int ai = 0; ai < 2; ++ai)
#pragma unroll
            for (int m = 0; m < 4; ++m) {
                const int row = u.pm * BM + ai * HALF + wr * 64 + m * 16 + fr;
                const f32x2 st = *(const f32x2*)(stats + 2 * (size_t)row);
                const size_t off = (size_t)row * DM + col0;
#pragma unroll
                for (int bj = 0; bj < 2; ++bj)
#pragma unroll
                    for (int n = 0; n < 2; ++n) { const f32x4 tv = *(const f32x4*)(T + off + bj * HALF + n * 16);
                        const f32x4 h1 = (tv - st.x) * st.y * gv[bj][n] + bv[bj][n];
                        *(f32x4*)(T + off + bj * HALF + n * 16) = h1 * ALPHA + acc[ai][bj][m][n]; }
            }
    }
};
}

namespace att {
constexpr int D = 128, NW = 8, QBLK = 32, KVBLK = 64, QB = 256;
constexpr int SHM_V = KVBLK * D * 2, SHM_K = KVBLK * D * 2;
constexpr int OFF_WS = 2 * SHM_V + 2 * SHM_K;
constexpr int OFF_NBK = OFF_WS + NW * 64 * 4;
constexpr int OFF_SCAN = OFF_NBK + SKV * 4;
constexpr int OFF_TB = OFF_SCAN + 256;
constexpr int ATT_LDS = OFF_TB + 576;
constexpr float SCALE = ATT_SCALE;
constexpr float THR = 8.f;
#define KSWZ(row, colB) ((row) * 256 + ((colB) ^ (((row) & 7) << 4)))
#define SBAR() __builtin_amdgcn_sched_barrier(0)
__device__ __forceinline__ int v_st(int k, int c) { const int kk = (k & ~0xC) | ((k & 4) << 1) | ((k & 8) >> 1); return ((kk >> 3) * 4 + (c >> 5)) * 512 + ((kk & 7) * 32 + (c & 31)) * 2; }
__device__ __forceinline__ int v_rd_base(int lane) { return ((lane & 3) << 3) | (((lane >> 2) & 3) << 6) | (((lane >> 4) & 1) << 5) | (((lane >> 5) & 1) << 8); }
constexpr int v_rd_off(int d0, int ks, int half) { return d0 * 512 + ks * 4096 + half * 2048; }
__device__ __forceinline__ int crow(int r, int hi) { return (r & 3) + 8 * (r >> 2) + 4 * hi; }
__device__ __forceinline__ bf16x8 load8(const bf16_t* p) { return *reinterpret_cast<const bf16x8*>(p); }
__device__ __forceinline__ void mask_tile(f32x16& p0, f32x16& p1, int dq) {
    const float NEG = -__builtin_inff();
#pragma unroll
    for (int r = 0; r < 16; ++r) {
        const int c = (r & 3) + 8 * (r >> 2);
        if (dq - c < 0) p0[r] = NEG;
        if (dq - c - 32 < 0) p1[r] = NEG;
    }
}
__device__ __forceinline__ void partialSM(f32x16& p0, f32x16& p1, float& m_reg, float& mn, float& alpha) {
    float pmax = p0[0];
#pragma unroll
    for (int r = 1; r < 16; ++r) pmax = fmaxf(pmax, p0[r]);
#pragma unroll
    for (int r = 0; r < 16; ++r) pmax = fmaxf(pmax, p1[r]);
    { auto rr = __builtin_amdgcn_permlane32_swap(__float_as_uint(pmax), __float_as_uint(pmax), false, false);
      pmax = fmaxf(__uint_as_float(rr[0]), __uint_as_float(rr[1])); }
    constexpr float C2 = 1.4426950408889634f * SCALE;
    if (__builtin_expect(__all((pmax - m_reg) * SCALE <= THR), 1)) { mn = m_reg; alpha = 1.f; }
    else { mn = fmaxf(m_reg, pmax); alpha = __builtin_amdgcn_exp2f((m_reg - mn) * C2); m_reg = mn; }
    const float mnL = -mn * C2;
#pragma unroll
    for (int r = 0; r < 16; ++r) p0[r] = fmaf(p0[r], C2, mnL);
#pragma unroll
    for (int r = 0; r < 16; ++r) p1[r] = fmaf(p1[r], C2, mnL);
#pragma unroll
    for (int r = 0; r < 16; ++r) p0[r] = __builtin_amdgcn_exp2f(p0[r]);
}
__device__ __forceinline__ void finishSM(f32x16& p0, f32x16& p1, float alpha, float& l_reg, bf16x8& pa0, bf16x8& pa1, bf16x8& pa2, bf16x8& pa3) {
#pragma unroll
    for (int r = 0; r < 16; ++r) p1[r] = __builtin_amdgcn_exp2f(p1[r]);
    float ps = 0;
#pragma unroll
    for (int r = 0; r < 16; ++r) ps += p0[r];
#pragma unroll
    for (int r = 0; r < 16; ++r) ps += p1[r];
    { auto rr = __builtin_amdgcn_permlane32_swap(__float_as_uint(ps), __float_as_uint(ps), false, false);
      ps = __uint_as_float(rr[0]) + __uint_as_float(rr[1]); }
    l_reg = l_reg * alpha + ps;
#define PK4(P, B_, OUT) do { unsigned a0 = cvt_pk_bf16(P[B_+0], P[B_+1]), a1 = cvt_pk_bf16(P[B_+2], P[B_+3]);                          \
        unsigned b0 = cvt_pk_bf16(P[B_+4], P[B_+5]), b1 = cvt_pk_bf16(P[B_+6], P[B_+7]);                                             \
        auto r0 = __builtin_amdgcn_permlane32_swap(a0, b0, false, false); auto r1 = __builtin_amdgcn_permlane32_swap(a1, b1, false, false); \
        u32x4 w = {r0[0], r1[0], r0[1], r1[1]}; OUT = *reinterpret_cast<bf16x8*>(&w); } while (0)
    PK4(p0, 0, pa0); PK4(p0, 8, pa1); PK4(p1, 0, pa2); PK4(p1, 8, pa3);
#undef PK4
}
template <int KB>
__device__ __forceinline__ void qkt(f32x16& p0, f32x16& p1, const char* K_lds, const float* nbk_t, int r32, int hi, const bf16x8* qr) {
    const f32x4* bp = (const f32x4*)(nbk_t + 4 * hi);
#pragma unroll
    for (int g = 0; g < 4; ++g) { const f32x4 a = bp[2 * g], b = bp[8 + 2 * g];
        p0[4 * g] = a[0]; p0[4 * g + 1] = a[1]; p0[4 * g + 2] = a[2]; p0[4 * g + 3] = a[3];
        p1[4 * g] = b[0]; p1[4 * g + 1] = b[1]; p1[4 * g + 2] = b[2]; p1[4 * g + 3] = b[3]; }
    const char* kb[4];
#pragma unroll
    for (int dd = 0; dd < 4; ++dd) kb[dd] = K_lds + KB * SHM_K + KSWZ(r32, (dd * 16 + hi * 8) * 2);
#pragma unroll
    for (int d0 = 0; d0 < 8; ++d0) { const char* a = kb[d0 & 3] + (d0 >> 2) * 128;
        bf16x8 b0 = *reinterpret_cast<const bf16x8*>(a);
        bf16x8 b1 = *reinterpret_cast<const bf16x8*>(a + 32 * 256);
        p0 = __builtin_amdgcn_mfma_f32_32x32x16_bf16(b0, qr[d0], p0, 0, 0, 0);
        p1 = __builtin_amdgcn_mfma_f32_32x32x16_bf16(b1, qr[d0], p1, 0, 0, 0); }
}
template <int VB>
__device__ __forceinline__ void pv_tile(f32x16* o, int vb0, bf16x8 pa0, bf16x8 pa1, bf16x8 pa2, bf16x8 pa3) {
#define TRRD(dst, off) asm volatile("ds_read_b64_tr_b16 %0, %1 offset:%2" : "=&v"(dst) : "v"(vb0), "i"(off) : "memory")
#define PV_D0(d0) do { s16x4 l0, l1, l2, l3, h0, h1, h2, h3; constexpr int b_ = VB * SHM_V + v_rd_off(d0, 0, 0); \
        TRRD(l0, b_); TRRD(h0, b_ + 2048); TRRD(l1, b_ + 4096); TRRD(h1, b_ + 6144); TRRD(l2, b_ + 8192); TRRD(h2, b_ + 10240); TRRD(l3, b_ + 12288); TRRD(h3, b_ + 14336); \
        asm volatile("s_waitcnt lgkmcnt(0)" ::: "memory"); SBAR();   \
        o[d0] = __builtin_amdgcn_mfma_f32_32x32x16_bf16(pa0, (bf16x8){l0[0], l0[1], l0[2], l0[3], h0[0], h0[1], h0[2], h0[3]}, o[d0], 0, 0, 0);   \
        o[d0] = __builtin_amdgcn_mfma_f32_32x32x16_bf16(pa1, (bf16x8){l1[0], l1[1], l1[2], l1[3], h1[0], h1[1], h1[2], h1[3]}, o[d0], 0, 0, 0);   \
        o[d0] = __builtin_amdgcn_mfma_f32_32x32x16_bf16(pa2, (bf16x8){l2[0], l2[1], l2[2], l2[3], h2[0], h2[1], h2[2], h2[3]}, o[d0], 0, 0, 0);   \
        o[d0] = __builtin_amdgcn_mfma_f32_32x32x16_bf16(pa3, (bf16x8){l3[0], l3[1], l3[2], l3[3], h3[0], h3[1], h3[2], h3[3]}, o[d0], 0, 0, 0); } while (0)
    PV_D0(0); PV_D0(1); PV_D0(2); PV_D0(3);
#undef PV_D0
#undef TRRD
}

struct BlockRef { const bf16_t* Q; const bf16_t* K; int P0; int row0; int h; };
struct Seam { bf16x8 qr[8]; bf16x8 st_v0, st_v1, st_k0, st_k1; };
constexpr size_t VDELTA = (WS_V - WS_K) / 2;
__device__ __forceinline__ bf16x8 load8o(const bf16_t* base, unsigned byteoff) { return *reinterpret_cast<const bf16x8*>((const char*)base + byteoff); }
#define ROWB(k0, rr) (rowoff + (unsigned)(((k0) + (rr)) * D * 2))
#define VMW() asm volatile("s_waitcnt vmcnt(0)" ::: "memory")
#define VMWN(n) asm volatile("s_waitcnt vmcnt(%0)" :: "i"(n) : "memory")
#define SLOAD_H(Kp, k0) do { S.st_v0 = load8o((Kp) + VDELTA, ROWB(k0, 0)); S.st_v1 = load8o((Kp) + VDELTA, ROWB(k0, 32));              \
                         S.st_k0 = load8o(Kp, ROWB(k0, 0)); S.st_k1 = load8o(Kp, ROWB(k0, 32)); } while (0)
#define SWRITE_HK(bf) do { *(bf16x8*)(K_lds + (bf) * SHM_K + kws) = S.st_k0; *(bf16x8*)(K_lds + (bf) * SHM_K + kws + 32 * 256) = S.st_k1; } while (0)
#define SWRITE_HV(bf) do { *(bf16x8*)(V_lds + (bf) * SHM_V + vst0) = S.st_v0; *(bf16x8*)(V_lds + (bf) * SHM_V + vst1) = S.st_v1; } while (0)
#define SWRITE_H(bf) do { SWRITE_HV(bf); SWRITE_HK(bf); } while (0)
__device__ __forceinline__ void prime(const BlockRef& cur, char* lds, Seam& S) {
    const int tid = threadIdx.x, wid = __builtin_amdgcn_readfirstlane(tid >> 6), lane = tid & 63, r32 = lane & 31, hi = lane >> 5;
    const int sr = tid >> 4, sc = (tid & 15) * 8, kws = KSWZ(sr, sc * 2); char* K_lds = lds + 2 * SHM_V;
    const unsigned rowoff = (unsigned)(sr * D + sc) * 2u, qoff = (unsigned)((wid * QBLK + r32) * D + hi * 8) * 2u;
#pragma unroll
    for (int d0 = 0; d0 < 8; ++d0) S.qr[d0] = load8o(cur.Q, qoff + d0 * 32);
    SLOAD_H(cur.K, 0); VMW(); SWRITE_HK(0);
    __syncthreads();
}
struct Item { int bh, qb; };
__device__ __forceinline__ Item decode(int id) { Item it; const int x = id >> 7, n = id & 127; it.bh = (n & 7) * 8 + x; it.qb = 15 - (n >> 3); return it; }
__device__ __forceinline__ BlockRef mkref(int id, const bf16_t* Q, const bf16_t* K) {
    const Item it = decode(id); BlockRef r;
    r.Q = Q + ((size_t)it.bh * SEQ + (size_t)it.qb * QB) * D; r.K = K + (size_t)it.bh * SKV * D;
    r.P0 = 64 + it.qb * QB; r.row0 = (it.bh >> 4) * SEQ + it.qb * QB; r.h = it.bh & 15; return r;
}
__device__ __forceinline__ int block(const BlockRef& cur, char* lds, Seam& S, const bf16_t* __restrict__ Qg, const bf16_t* __restrict__ Kg, const float* __restrict__ nbkg, const bf16_t* __restrict__ Zg, bf16_t* __restrict__ G) {
    const int tid = threadIdx.x, wid = __builtin_amdgcn_readfirstlane(tid >> 6), lane = tid & 63, r32 = lane & 31, hi = lane >> 5;
    const int NT = (cur.P0 + QB - 1) / KVBLK + 1;
    const int qlo = cur.P0 + wid * QBLK, qm = qlo + r32 - 4 * hi;
    char* V_lds = lds; char* K_lds = lds + 2 * SHM_V;
    float* ws = (float*)(lds + OFF_WS) + wid * 64; float* li_l = ws; float* al_l = ws + 32;
    const float* nbk = (const float*)(lds + OFF_NBK);
    volatile float* ctlf = (volatile float*)(lds + OFF_SCAN); const float* tb = (const float*)(lds + OFF_TB);
    float m_reg = -1e30f, l_reg = 0; f32x16 o[4] = {};
    const int sr = tid >> 4, sc = (tid & 15) * 8, vst0 = v_st(sr, sc), vst1 = v_st(32 + sr, sc), kws = KSWZ(sr, sc * 2);
    const int vb0 = (int)(uintptr_t)V_lds + v_rd_base(lane);
    const bf16_t* Kh = cur.K;
    const unsigned rowoff = (unsigned)(sr * D + sc) * 2u, qoff = (unsigned)((wid * QBLK + r32) * D + hi * 8) * 2u;
    int toff, NS, nxt_id;
    {
        u32x4 kd[8];
        const unsigned koff = (unsigned)((cur.P0 + wid * QBLK + r32) * D + hi * 8) * 2u;
#pragma unroll
        for (int d0 = 0; d0 < 8; ++d0) kd[d0] = *reinterpret_cast<const u32x4*>((const char*)Kh + koff + d0 * 32);
        const float nb_i = nbkg[cur.P0 + wid * QBLK + r32];
        float ds = 0.f, qn = 0.f;
#pragma unroll
        for (int d0 = 0; d0 < 8; ++d0) { const u32x4 qq = *reinterpret_cast<const u32x4*>(&S.qr[d0]); const u32x4 kk = kd[d0];
            ds += bflo(qq.x) * bflo(kk.x) + bfhi(qq.x) * bfhi(kk.x) + bflo(qq.y) * bflo(kk.y) + bfhi(qq.y) * bfhi(kk.y)
                + bflo(qq.z) * bflo(kk.z) + bfhi(qq.z) * bfhi(kk.z) + bflo(qq.w) * bflo(kk.w) + bfhi(qq.w) * bfhi(kk.w);
            qn += bflo(qq.x) * bflo(qq.x) + bfhi(qq.x) * bfhi(qq.x) + bflo(qq.y) * bflo(qq.y) + bfhi(qq.y) * bfhi(qq.y)
                + bflo(qq.z) * bflo(qq.z) + bfhi(qq.z) * bfhi(qq.z) + bflo(qq.w) * bflo(qq.w) + bfhi(qq.w) * bfhi(qq.w); }
        { auto rr = __builtin_amdgcn_permlane32_swap(__float_as_uint(ds), __float_as_uint(ds), false, false); ds = __uint_as_float(rr[0]) + __uint_as_float(rr[1]); }
        { auto rr = __builtin_amdgcn_permlane32_swap(__float_as_uint(qn), __float_as_uint(qn), false, false); qn = __uint_as_float(rr[0]) + __uint_as_float(rr[1]); }
        m_reg = ds + nb_i;
        float mmin = m_reg, qmx = qn;
#pragma unroll
        for (int o_ = 1; o_ < 32; o_ <<= 1) { mmin = fminf(mmin, __shfl_xor(mmin, o_)); qmx = fmaxf(qmx, __shfl_xor(qmx, o_)); }
        if (lane == 0) { ctlf[16 + wid] = mmin; ctlf[24 + wid] = qmx; }
        __syncthreads();
        float m_min = ctlf[16], q2 = ctlf[24];
#pragma unroll
        for (int w = 1; w < 8; ++w) { m_min = fminf(m_min, ctlf[16 + w]); q2 = fmaxf(q2, ctlf[24 + w]); }
        nxt_id = ((volatile int*)ctlf)[8];
        constexpr float C2 = 1.4426950408889634f * SCALE;
        const int t = lane + 1;
        const float bound = (sqrtf(q2 * tb[2 * t]) * 1.001f + tb[2 * t + 1] - m_min) * C2;
        const bool nonskip = (t < NT) && !(bound < -160.f);
        const unsigned long long mask = __ballot(nonskip);
        const int t_start = mask ? __ffsll((unsigned long long)mask) : 1;
        toff = __builtin_amdgcn_readfirstlane((t_start - 1) & ~1);
        NS = NT - toff;
    }
    const BlockRef nxt = nxt_id < 0 ? cur : mkref(nxt_id, Qg, Kg);
#define RESC(a) do { if (__any((a) < 1.f)) { if (hi == 0) al_l[r32] = (a); asm volatile("s_waitcnt lgkmcnt(0)" ::: "memory");              \
                     _Pragma("unroll") for (int d_ = 0; d_ < 4; ++d_) _Pragma("unroll") for (int r = 0; r < 16; ++r) o[d_][r] *= al_l[crow(r, hi)]; } } while (0)
#define KBASE(t) (((t) + toff) * KVBLK)
#define MASKT(P0_, P1_, t) do { const int kb_ = KBASE(t); if (kb_ + KVBLK - 1 > qlo) mask_tile(P0_, P1_, qm - kb_); } while (0)
#define SEAM_K0() do { VMWN(8); SWRITE_HK(0); SBAR(); } while (0)
    f32x16 pA0, pA1, pB0, pB1; float mnA, mnB, alA, alB; bf16x8 pa0, pa1, pa2, pa3;
    SWRITE_HV(0); SBAR();
    SLOAD_H(Kh, KBASE(1));
    SBAR(); qkt<0>(pA0, pA1, K_lds, nbk, r32, hi, S.qr);
    partialSM(pA0, pA1, m_reg, mnA, alA);
    VMW(); SWRITE_H(1);
    __syncthreads();
#define HALF_STEP(PX0, PX1, mnX, alX, PY0, PY1, alY, t, KB, VB, SB) do {                                                      \
        SBAR(); qkt<KB>(PX0, PX1, K_lds, nbk + KBASE(t), r32, hi, S.qr);                                                   \
        finishSM(PY0, PY1, alY, l_reg, pa0, pa1, pa2, pa3); SBAR();                                                           \
        if ((t) + 1 < NS) { SLOAD_H(Kh, KBASE((t) + 1)); SBAR(); }                                                        \
        pv_tile<VB>(o, vb0, pa0, pa1, pa2, pa3); MASKT(PX0, PX1, (t)); partialSM(PX0, PX1, m_reg, mnX, alX);                  \
        __syncthreads();                                                                                                      \
        if ((t) + 1 < NS) { VMW(); SWRITE_H(SB); }                                                                            \
        RESC(alX); __syncthreads(); } while (0)
    for (int t = 1; t + 1 < NS; t += 2) {
        HALF_STEP(pB0, pB1, mnB, alB, pA0, pA1, alA, t, 1, 0, 0);
        HALF_STEP(pA0, pA1, mnA, alA, pB0, pB1, alB, t + 1, 0, 1, 1);
    }
    SLOAD_H(nxt.K, 0); SBAR();
#pragma unroll
    for (int d0 = 0; d0 < 8; ++d0) S.qr[d0] = load8o(nxt.Q, qoff + d0 * 32);
    SBAR();
    finishSM(pA0, pA1, alA, l_reg, pa0, pa1, pa2, pa3); SBAR();
    pv_tile<0>(o, vb0, pa0, pa1, pa2, pa3);
    SBAR(); SEAM_K0();
    if (hi == 0) li_l[r32] = l_reg; asm volatile("s_waitcnt lgkmcnt(0)" ::: "memory");
    {
        float* stgA = (float*)(lds + (wid < 4 ? SHM_V + wid * 4096 : 2 * SHM_V + SHM_K + (wid - 4) * 4096));
        float* stgB = (float*)(lds + ATT_LDS + wid * 4096);
        const bf16_t* zp = Zg + (size_t)(cur.row0 + wid * QBLK) * DM + cur.h * HD + (size_t)(lane >> 4) * DM + (lane & 15) * 8;
        bf16_t* gp = G + (size_t)(cur.row0 + wid * QBLK) * DM + cur.h * HD + (size_t)(lane >> 4) * DM + (lane & 15) * 8;
        u32x4 zv[2][4];
#pragma unroll
        for (int p = 0; p < 2; ++p)
#pragma unroll
            for (int k = 0; k < 4; ++k) zv[p][k] = *(const u32x4*)(zp + (size_t)(16 * p + 4 * k) * DM);
        float rli[16];
#pragma unroll
        for (int r = 0; r < 16; ++r) rli[r] = __builtin_amdgcn_rcpf(li_l[crow(r, hi)]);
#pragma unroll
        for (int p = 0; p < 2; ++p) {
#pragma unroll
            for (int rr = 0; rr < 8; ++rr) { const int r = 8 * p + rr; float* dst = ((rr >> 2) ? stgB : stgA) + ((rr & 3) + 4 * hi) * 128 + r32;
#pragma unroll
                for (int d0 = 0; d0 < 4; ++d0) dst[d0 * 32] = o[d0][r] * rli[r]; }
            asm volatile("s_waitcnt lgkmcnt(0)" ::: "memory");
#pragma unroll
            for (int k = 0; k < 4; ++k) { const float* src = ((k >> 1) ? stgB : stgA) + (((k & 1) * 4 + (lane >> 4)) * 128 + (lane & 15) * 8);
                const f32x4 a0 = *(const f32x4*)src, a1 = *(const f32x4*)(src + 4); const u32x4 zw = zv[p][k];
                u32x4 w;
                w.x = cvt_pk_bf16(a0[0] * silu_f(bflo(zw.x)), a0[1] * silu_f(bfhi(zw.x))); w.y = cvt_pk_bf16(a0[2] * silu_f(bflo(zw.y)), a0[3] * silu_f(bfhi(zw.y)));
                w.z = cvt_pk_bf16(a1[0] * silu_f(bflo(zw.z)), a1[1] * silu_f(bfhi(zw.z))); w.w = cvt_pk_bf16(a1[2] * silu_f(bflo(zw.w)), a1[3] * silu_f(bfhi(zw.w)));
                *(u32x4*)(gp + (size_t)(16 * p + 4 * k) * DM) = w; }
            asm volatile("s_waitcnt lgkmcnt(0)" ::: "memory");
        }
    }
    __syncthreads();
    return nxt_id;
#undef RESC
#undef KBASE
#undef MASKT
#undef SEAM_K0
#undef HALF_STEP
}
#undef ROWB
#undef VMWN
#undef SLOAD_H
#undef SWRITE_HK
#undef SWRITE_HV
#undef SWRITE_H

__device__ __forceinline__ void load_nbk(const float* __restrict__ lf, char* lds) {
    float* nbk = (float*)(lds + OFF_NBK); float* scr = (float*)(lds + OFF_SCAN);
    const int tid = threadIdx.x, lane = tid & 63, wid = tid >> 6, base = tid * 9;
    float v[9]; float s = 0.f;
#pragma unroll
    for (int j = 0; j < 9; ++j) { const int p = base + j; v[j] = p < LTOT ? lf[p] : 0.f; s += v[j]; }
    float incl = s;
#pragma unroll
    for (int off = 1; off < 64; off <<= 1) { const float t = __shfl_up(incl, off); if (lane >= off) incl += t; }
    if (lane == 63) scr[wid] = incl;
    __syncthreads();
    float wp = 0.f;
#pragma unroll
    for (int w = 0; w < 8; ++w) if (w < wid) wp += scr[w];
    float c = wp + incl - s;
    constexpr float INV = 1.0f / SCALE;
#pragma unroll
    for (int j = 0; j < 9; ++j) { c += v[j]; const int p = base + j; if (p < LTOT) { const int kk = p < NMETA ? p : p + 48; nbk[kk] = -c * INV; } }
    if (tid < 48) nbk[16 + tid] = -1e30f;
    __syncthreads();
}
__device__ __forceinline__ void attn_prep(char* lds, const bf16_t* __restrict__ K, const float* __restrict__ logf, float* __restrict__ NBKG, float* __restrict__ TBG) {
    const int tid = threadIdx.x, lane = tid & 63, wid = tid >> 6;
    float* nbk = (float*)(lds + OFF_NBK); float* slot = (float*)(lds + ATT_LDS);
    for (int w = blockIdx.x; w < 256; w += gridDim.x) {
        const int bh = w >> 2, part = w & 3, t0 = part * 17, t1 = (t0 + 17 < 65) ? t0 + 17 : 65;
        if (part == 0) {
            load_nbk(logf + (size_t)bh * LTOT, lds);
            for (int e = tid; e < SKV; e += 512) NBKG[(size_t)bh * SKV + e] = nbk[e];
            if (tid < 65) { float mx = -3e38f; const int lo_ = tid * 64, cnt = tid == 0 ? NMETA : 64; for (int j = 0; j < cnt; ++j) mx = fmaxf(mx, nbk[lo_ + j]); TBG[((size_t)bh * 65 + tid) * 2 + 1] = mx; }
        }
        const bf16_t* Kb = K + (size_t)bh * SKV * D;
        for (int t = t0; t < t1; ++t) {
            float m2 = 0.f;
#pragma unroll
            for (int hf = 0; hf < 2; ++hf) { const int row = t * 64 + hf * 32 + (tid >> 4); const u32x4 v = *(const u32x4*)(Kb + (size_t)row * D + (tid & 15) * 8);
                float ss = bflo(v.x) * bflo(v.x) + bfhi(v.x) * bfhi(v.x) + bflo(v.y) * bflo(v.y) + bfhi(v.y) * bfhi(v.y) + bflo(v.z) * bflo(v.z) + bfhi(v.z) * bfhi(v.z) + bflo(v.w) * bflo(v.w) + bfhi(v.w) * bfhi(v.w);
                ss += __shfl_xor(ss, 1); ss += __shfl_xor(ss, 2); ss += __shfl_xor(ss, 4); ss += __shfl_xor(ss, 8);
                m2 = fmaxf(m2, ss); }
            m2 = fmaxf(m2, __shfl_xor(m2, 16)); m2 = fmaxf(m2, __shfl_xor(m2, 32));
            if (lane == 0) slot[(t - t0) * 8 + wid] = m2;
        }
        __syncthreads();
        if (tid < t1 - t0) { float mx = slot[tid * 8];
#pragma unroll
            for (int w2 = 1; w2 < 8; ++w2) mx = fmaxf(mx, slot[tid * 8 + w2]);
            TBG[((size_t)bh * 65 + t0 + tid) * 2] = mx; }
        __syncthreads();
    }
}
__device__ __forceinline__ int pop_item(unsigned* qc, unsigned x0) {
    for (unsigned i = 0; i < 8; ++i) { const unsigned q = (x0 + i) & 7u; const unsigned n = __hip_atomic_fetch_add(qc + 64 * q, 1u, __ATOMIC_RELAXED, __HIP_MEMORY_SCOPE_AGENT); if (n < 128u) return (int)(q * 128u + n); }
    return -1;
}
__device__ __forceinline__ void attn_phase(char* lds, const bf16_t* Q, const bf16_t* K, const bf16_t* Zg, bf16_t* G, const float* NBKG, const float* TBG, unsigned* qc, unsigned xcc) {
    const int tid = threadIdx.x;
    volatile int* ctl = (volatile int*)(lds + OFF_SCAN);
    float* nbk = (float*)(lds + OFF_NBK); float* tb = (float*)(lds + OFF_TB);
    if (tid == 0) ctl[8] = pop_item(qc, xcc);
    __syncthreads();
    int cur_id = ctl[8];
    __syncthreads();
    if (cur_id < 0) return;
    BlockRef cur = mkref(cur_id, Q, K);
    Seam S;
    prime(cur, lds, S);
    for (;;) {
        const int bh = decode(cur_id).bh, NTc = (cur.P0 + QB - 1) / KVBLK + 1;
        if (tid == 0) ctl[8] = pop_item(qc, xcc);
        { const float* src = NBKG + (size_t)bh * SKV; for (int e = tid * 4; e < NTc * 64; e += 2048) *(f32x4*)(nbk + e) = *(const f32x4*)(src + e);
          const float* ts = TBG + (size_t)bh * 130; if (tid < 130) tb[tid] = ts[tid]; }
        const int nxt_id = block(cur, lds, S, Q, K, NBKG + (size_t)bh * SKV, Zg, G);
        if (nxt_id < 0) break;
        cur_id = nxt_id; cur = mkref(cur_id, Q, K);
    }
}
#undef VMW
#undef SBAR
#undef KSWZ
}

__device__ __forceinline__ f32x4 wave_gemm16(const bf16_t* __restrict__ A, int lda, const bf16_t* __restrict__ Bt, int ldb, int K, int lane) {
    const int fr = lane & 15, fq = lane >> 4;
    const bf16_t* ap = A + (size_t)fr * lda + fq * 8; const bf16_t* bp = Bt + (size_t)fr * ldb + fq * 8;
    f32x4 acc = {0.f, 0.f, 0.f, 0.f};
#pragma unroll 8
    for (int k0 = 0; k0 < K; k0 += 32) {
        const bf16x8 a = *(const bf16x8*)(ap + k0), b = *(const bf16x8*)(bp + k0);
        acc = __builtin_amdgcn_mfma_f32_16x16x32_bf16(a, b, acc, 0, 0, 0);
    }
    return acc;
}

#define XB_TMO      128
#define XB_XCNT(j)  (256  + 64 * (j))
#define XB_XSUB(j)  (1280 + 64 * (j))
#define XB_XGEN(j)  (2304 + 64 * (j))
#define XB_TOP      3328
#define XB_TOPGEN   3392
#define XCD_BAR_WORDS 3456
#define XB_SPIN_CAP (1u << 18)
__device__ __forceinline__ unsigned xb_ld(unsigned* p)              { return __hip_atomic_load(p, __ATOMIC_RELAXED, __HIP_MEMORY_SCOPE_AGENT); }
__device__ __forceinline__ unsigned xb_add(unsigned* p, unsigned v) { return __hip_atomic_fetch_add(p, v, __ATOMIC_RELAXED, __HIP_MEMORY_SCOPE_AGENT); }
__device__ __forceinline__ unsigned xb_xcc_id() { return (unsigned)__builtin_amdgcn_s_getreg((3 << 11) | 20) & 0xFu; }
#define XB_SPIN(cond, bar) do { unsigned _sp = 0; while (cond) { __builtin_amdgcn_s_sleep(1); \
    if ((++_sp & 255u) == 0u) { if (xb_ld(&(bar)[XB_TMO])) break; if (_sp > XB_SPIN_CAP) { atomicAdd(&(bar)[XB_TMO], 1u); break; } } } } while (0)
struct XcdBarrier { unsigned* bar; unsigned x; volatile LAS unsigned* st; };
__device__ __forceinline__ XcdBarrier xcd_barrier_post(unsigned* bar, volatile LAS unsigned* st) {
    XcdBarrier b; b.bar = bar; b.x = xb_xcc_id(); b.st = st;
    if (threadIdx.x == 0) (void)xb_add(&bar[XB_XCNT(b.x)], 1u);
    return b;
}
__device__ __forceinline__ void xcd_barrier_complete(unsigned* bar, unsigned x, unsigned& nloc, unsigned& nx) {
    const unsigned G = gridDim.x * gridDim.y * gridDim.z;
    unsigned sum, cnt, mine, sp = 0u;
    for (;;) {
        sum = 0u; cnt = 0u; mine = 0u;
#pragma unroll
        for (unsigned j = 0; j < 16; ++j) { const unsigned c = xb_ld(&bar[XB_XCNT(j)]); sum += c; cnt += (c > 0u) ? 1u : 0u; mine = (j == x) ? c : mine; }
        if (sum == G) break;
        __builtin_amdgcn_s_sleep(1);
        if ((++sp & 255u) == 0u) { if (xb_ld(&bar[XB_TMO])) break; if (sp > XB_SPIN_CAP) { atomicAdd(&bar[XB_TMO], 1u); break; } }
    }
    nloc = mine > 0u ? mine : 1u; nx = cnt > 0u ? cnt : 1u;
}
__device__ __forceinline__ void xcd_barrier(const XcdBarrier& b) {
    asm volatile("s_waitcnt vmcnt(0)" ::: "memory");
    __syncthreads();
    if (threadIdx.x == 0) {
        unsigned* bar = b.bar;
        __builtin_amdgcn_s_waitcnt(0);
        unsigned nloc = b.st[0], nx = b.st[1];
        if (nloc == 0u) { xcd_barrier_complete(bar, b.x, nloc, nx); b.st[0] = nloc; b.st[1] = nx; }
        const unsigned old = xb_add(&bar[XB_XSUB(b.x)], 1u);
        const unsigned gen = old / nloc;
        if (old + 1u == (gen + 1u) * nloc) {
            __builtin_amdgcn_fence(__ATOMIC_RELEASE, "agent");
            asm volatile("s_waitcnt vmcnt(0)" ::: "memory");
            const unsigned og = xb_add(&bar[XB_TOP], 1u);
            const unsigned tg = og / nx;
            if (og + 1u == (tg + 1u) * nx) xb_add(&bar[XB_TOPGEN], 1u);
            else XB_SPIN(xb_ld(&bar[XB_TOPGEN]) == tg, bar);
            __builtin_amdgcn_fence(__ATOMIC_ACQUIRE, "agent");
            xb_add(&bar[XB_XGEN(b.x)], 1u);
            asm volatile("s_waitcnt vmcnt(0)" ::: "memory");
        } else {
            XB_SPIN(xb_ld(&bar[XB_XGEN(b.x)]) == gen, bar);
            __builtin_amdgcn_fence(__ATOMIC_ACQUIRE, "agent");
            asm volatile("s_waitcnt vmcnt(0)" ::: "memory");
        }
    }
    __syncthreads();
}

struct Args {
    const float* x; const float* meta; const float* w_in; const float* b_f; const float* w_out; const float* ln0_g; const float* ln0_b;
    const float* pw_in; const float* pw_grp; const float* p_scale; const float* pw_out; const float* ln1_g; const float* ln1_b;
    float* out; unsigned char* ws; int ph_lo, ph_hi;
};
constexpr int N_PHASES = 11;

__device__ __forceinline__ void p0_transpose_item(const float* __restrict__ W, int K, int ldw, int nblk, bf16_t* __restrict__ WT, LAS float* scr, int item, int lane) {
    const int kb = item / nblk, nb = item % nblk, k0 = 64 * kb, n0 = 32 * nb;
#pragma unroll 8
    for (int i = 0; i < 32; ++i) { const int kk = 2 * i + (lane >> 5); scr[kk * 33 + (lane & 31)] = W[(size_t)(k0 + kk) * ldw + n0 + (lane & 31)]; }
    LDS_WAIT(); asm volatile("" ::: "memory");
    const int c = lane & 7;
#pragma unroll
    for (int j = 0; j < 4; ++j) { const int n = (lane >> 3) + 8 * j; const LAS float* s = scr + (8 * c) * 33 + n;
        u32x4 o; o.x = cvt_pk_bf16(s[0 * 33], s[1 * 33]); o.y = cvt_pk_bf16(s[2 * 33], s[3 * 33]); o.z = cvt_pk_bf16(s[4 * 33], s[5 * 33]); o.w = cvt_pk_bf16(s[6 * 33], s[7 * 33]);
        *(u32x4*)(WT + (size_t)(n0 + n) * K + k0 + 8 * c) = o; }
    LDS_WAIT(); asm volatile("" ::: "memory");
}
__device__ __forceinline__ void row_to_bf16(const float* __restrict__ xrow, bf16_t* __restrict__ orow, int lane) {
    const f32x4* xr = (const f32x4*)xrow + lane; u32x2* o8 = (u32x2*)orow + lane;
    f32x4 v[8];
#pragma unroll
    for (int j = 0; j < 8; ++j) v[j] = xr[64 * j];
#pragma unroll
    for (int j = 0; j < 8; ++j) { u32x2 w; w.x = cvt_pk_bf16(v[j][0], v[j][1]); w.y = cvt_pk_bf16(v[j][2], v[j][3]); o8[64 * j] = w; }
}
__device__ __forceinline__ void ln_row(const float* __restrict__ trow, const float* __restrict__ g, const float* __restrict__ bb, bf16_t* ob, float* of, float* st, int lane) {
    const f32x4* xr = (const f32x4*)trow + lane;
    f32x4 v[8]; float s = 0.f;
#pragma unroll
    for (int j = 0; j < 8; ++j) { v[j] = xr[64 * j]; s += (v[j][0] + v[j][1]) + (v[j][2] + v[j][3]); }
    const float mean = wave_sum(s) * (1.f / DM); float s2 = 0.f;
#pragma unroll
    for (int j = 0; j < 8; ++j) { const f32x4 d = v[j] - mean; s2 += (d[0] * d[0] + d[1] * d[1]) + (d[2] * d[2] + d[3] * d[3]); }
    const float rstd = 1.0f / sqrtf(wave_sum(s2) * (1.f / DM) + LN_EPS);
    if (st && lane == 0) { st[0] = mean; st[1] = rstd; }
#pragma unroll
    for (int j = 0; j < 8; ++j) {
        const f32x4 gv = ((const f32x4*)g)[lane + 64 * j], bv = ((const f32x4*)bb)[lane + 64 * j];
        const f32x4 y = (v[j] - mean) * rstd * gv + bv;
        if (of) ((f32x4*)of)[lane + 64 * j] = y;
        if (ob) { u32x2 w; w.x = cvt_pk_bf16(y[0], y[1]); w.y = cvt_pk_bf16(y[2], y[3]); ((u32x2*)ob)[lane + 64 * j] = w; }
    }
}

__global__ void __launch_bounds__(512, 2) fwd(Args a) {
    extern __shared__ __attribute__((aligned(16))) unsigned char lds[];
    const int tid = threadIdx.x, lane = tid & 63, wid = __builtin_amdgcn_readfirstlane(tid >> 6);
    const int G = gridDim.x, bx = blockIdx.x;
    const int gw = bx * 8 + wid, NGW = G * 8;
    unsigned char* ws = a.ws;
    float* LOGF = (float*)(ws + WS_LOGF); bf16_t* MB = (bf16_t*)(ws + WS_MB); float* PM = (float*)(ws + WS_PM); bf16_t* GM = (bf16_t*)(ws + WS_GM);
    float* NBKG = (float*)(ws + WS_NBKG); float* TBG = (float*)(ws + WS_TBG);
    float* T0M = (float*)(ws + WS_T0M); bf16_t* H1MB = (bf16_t*)(ws + WS_H1MB); float* UM = (float*)(ws + WS_UM); float* STATS = (float*)(ws + WS_STATS);
    bf16_t* W1T = (bf16_t*)(ws + WS_W1T); bf16_t* WOT = (bf16_t*)(ws + WS_WOT); bf16_t* WPT = (bf16_t*)(ws + WS_WPT); bf16_t* WGT = (bf16_t*)(ws + WS_WGT); bf16_t* WO2T = (bf16_t*)(ws + WS_WO2T);
    bf16_t* H0B = (bf16_t*)(ws + WS_H0B); bf16_t* GB = H0B; bf16_t* EB = H0B;
    bf16_t* QB_ = (bf16_t*)(ws + WS_Q); bf16_t* H1B = QB_;
    bf16_t* KB_ = (bf16_t*)(ws + WS_K); bf16_t* UB = KB_;
    bf16_t* VB_ = (bf16_t*)(ws + WS_V); bf16_t* Z1B = VB_;
    bf16_t* ZB = (bf16_t*)(ws + WS_Z); bf16_t* DPB = ZB;
    const int lo = a.ph_lo, hi = a.ph_hi;
    volatile LAS unsigned* bst = (volatile LAS unsigned*)((LAS unsigned char*)lds + 131072);
    if (tid < 2) bst[tid] = 0u;
    __syncthreads();
    unsigned* BARW = (unsigned*)ws;
    XcdBarrier bar; bar.bar = BARW; bar.x = 0; bar.st = bst;
#ifdef ONLY_PHASE
#define IN(k) ((k) == ONLY_PHASE && lo <= (k) && (k) < hi)
#else
#define IN(k) (lo <= (k) && (k) < hi)
#endif
#define SEAM(k) do { if (IN(k) && IN((k) + 1)) { if ((k) == 0) { cg::this_grid().sync(); bar = xcd_barrier_post(BARW, bst); } else xcd_barrier(bar); } } while (0)

    if (IN(0)) {
        if (bx == 0) for (int e = tid; e < 4096; e += 512) BARW[e] = 0u;
        LAS float* scr = (LAS float*)((LAS unsigned char*)lds + wid * 8448);
        constexpr int I1 = 32 * 256, IO = 32 * 64, IP = 32 * 128, IG1 = 8 * 16, IO2 = 32 * 64;
        constexpr int NITEMS = I1 + IO + IP + 4 * IG1 + IO2;
        for (int it = gw; it < NITEMS; it += NGW) {
            int r = it;
            if (r < I1) { p0_transpose_item(a.w_in, DM, N1F, 256, W1T, scr, r, lane); continue; } r -= I1;
            if (r < IO) { p0_transpose_item(a.w_out, DM, DM, 64, WOT, scr, r, lane); continue; } r -= IO;
            if (r < IP) { p0_transpose_item(a.pw_in, DM, 2 * DM, 128, WPT, scr, r, lane); continue; } r -= IP;
            if (r < 4 * IG1) { const int gq = r / IG1; p0_transpose_item(a.pw_grp + (size_t)gq * 512 * 512, 512, 512, 16, WGT + (size_t)gq * 512 * 512, scr, r % IG1, lane); continue; } r -= 4 * IG1;
            p0_transpose_item(a.pw_out, DM, DM, 64, WO2T, scr, r, lane);
        }
        for (int e = bx * 512 + tid; e < 16 * DM; e += G * 512) { const int k = e >> 4, n = e & 15; const float w = a.w_in[(size_t)k * N1F + N1 + n];
            W1T[(size_t)(N1 + n) * DM + k] = (bf16_t)(cvt_pk_bf16(w, 0.f) & 0xffffu); }
        for (int m = gw; m < M; m += NGW) row_to_bf16(a.x + (size_t)m * DM, H0B + (size_t)m * DM, lane);
        for (int m = gw; m < NMETA; m += NGW) row_to_bf16(a.meta + (size_t)m * DM, MB + (size_t)m * DM, lane);
        for (int e = bx * 512 + tid; e < NB * NH * 768 * 2; e += G * 512) { const int kv = e & 1, r = e >> 1, bh = r / 768, c = r % 768;
            u32x4 z = {0u, 0u, 0u, 0u}; *(u32x4*)((kv ? VB_ : KB_) + ((size_t)bh * SKV + 16) * HD + (size_t)c * 8) = z; }
    }
    SEAM(0);

    if (IN(1)) {
        const int fr = lane & 15, fq = lane >> 4;
        for (int t = gw; t < 513 + 1024; t += NGW) {
            if (t < 513) {
                const f32x4 acc = wave_gemm16(MB, DM, W1T + (size_t)t * 16 * DM, DM, DM, lane);
                const int n = t * 16 + fr;
#pragma unroll
                for (int i = 0; i < 4; ++i) {
                    const int r = 4 * fq + i; PM[(size_t)r * N1F + n] = acc[i];
                    if (n >= 2048 && n < 6144) { const int kv = n >= 4096, cc = n - (kv ? 4096 : 2048), h = cc >> 7, d = cc & 127; const bf16_t v = (bf16_t)(cvt_pk_bf16(acc[i], 0.f) & 0xffffu);
#pragma unroll
                        for (int b = 0; b < NB; ++b) (kv ? VB_ : KB_)[((size_t)(b * NH + h) * SKV + r) * HD + d] = v; }
                    if (n >= N1) { const float lf = logsig_f(acc[i] + a.b_f[fr]);
#pragma unroll
                        for (int b = 0; b < NB; ++b) LOGF[(size_t)(b * NH + fr) * LTOT + r] = lf; }
                }
            } else {
                const int t2 = t - 513;
                const f32x4 acc = wave_gemm16(H0B + (size_t)t2 * 16 * DM, DM, W1T + (size_t)N1 * DM, DM, DM, lane);
                const float bf = a.b_f[fr];
#pragma unroll
                for (int i = 0; i < 4; ++i) { const int row = t2 * 16 + 4 * fq + i, b = row >> 12, ii = row & 4095;
                    LOGF[(size_t)(b * NH + fr) * LTOT + NMETA + ii] = logsig_f(acc[i] + bf); }
            }
        }
        pg8::Gemm g{H0B, W1T, DM, DM, DM, 0}; pg8::StaticOrder S; S.init(M, N1, G, bx);
        pg8::EpiQKVZ E{QB_, KB_, VB_, ZB};
        pg8::gemm_phase<pg8::EpiQKVZ, pg8::StaticOrder, true>((LAS unsigned char*)lds, g, S, E);
    }
    SEAM(1);

    if (IN(2)) { att::attn_prep((char*)lds, KB_, LOGF, NBKG, TBG); }
    SEAM(2);

    if (IN(3)) {
        for (int task = gw; task < 256; task += NGW) {
            const int h = task >> 4, i = task & 15; const float bf = a.b_f[h];
            const float q0 = PM[(size_t)i * N1F + h * HD + 2 * lane], q1 = PM[(size_t)i * N1F + h * HD + 2 * lane + 1];
            float ci = 0.f; for (int p = 0; p <= i; ++p) ci += logsig_f(PM[(size_t)p * N1F + N1 + h] + bf);
            float cj = 0.f, mx = -1e30f, l = 0.f, o0 = 0.f, o1 = 0.f;
            for (int j = 0; j <= i; ++j) {
                cj += logsig_f(PM[(size_t)j * N1F + N1 + h] + bf);
                const float k0 = PM[(size_t)j * N1F + 2048 + h * HD + 2 * lane], k1 = PM[(size_t)j * N1F + 2048 + h * HD + 2 * lane + 1];
                const float s = wave_sum(q0 * k0 + q1 * k1) * ATT_SCALE + ci - cj;
                const float mn = fmaxf(mx, s), al = __expf(mx - mn), p = __expf(s - mn);
                const float v0 = PM[(size_t)j * N1F + 4096 + h * HD + 2 * lane], v1 = PM[(size_t)j * N1F + 4096 + h * HD + 2 * lane + 1];
                l = l * al + p; o0 = o0 * al + p * v0; o1 = o1 * al + p * v1; mx = mn;
            }
            const float z0 = PM[(size_t)i * N1F + 6144 + h * HD + 2 * lane], z1 = PM[(size_t)i * N1F + 6144 + h * HD + 2 * lane + 1];
            const float rl = 1.0f / l;
            *(unsigned*)(GM + (size_t)i * DM + h * HD + 2 * lane) = cvt_pk_bf16(o0 * rl * silu_f(z0), o1 * rl * silu_f(z1));
        }
        att::attn_phase((char*)lds, QB_, KB_, ZB, GB, NBKG, TBG, BARW + 3584, xb_xcc_id());
    }
    SEAM(3);

    if (IN(4)) {
        const int fr = lane & 15, fq = lane >> 4;
        for (int t = gw; t < 128; t += NGW) {
            const f32x4 acc = wave_gemm16(GM, DM, WOT + (size_t)t * 16 * DM, DM, DM, lane);
#pragma unroll
            for (int i = 0; i < 4; ++i) { const int r = 4 * fq + i, n = t * 16 + fr; T0M[(size_t)r * DM + n] = ALPHA * a.meta[(size_t)r * DM + n] + acc[i]; }
        }
        pg8::Gemm g{GB, WOT, DM, DM, DM, 0}; pg8::StaticOrder S; S.init(M, DM, G, bx);
        pg8::EpiT0 E{a.x, a.out};
        pg8::gemm_phase<pg8::EpiT0, pg8::StaticOrder, true>((LAS unsigned char*)lds, g, S, E);
    }
    SEAM(4);

    if (IN(5)) {
        for (int m = gw; m < M + NMETA; m += NGW) {
            if (m < M) ln_row(a.out + (size_t)m * DM, a.ln0_g, a.ln0_b, H1B + (size_t)m * DM, nullptr, STATS + 2 * (size_t)m, lane);
            else ln_row(T0M + (size_t)(m - M) * DM, a.ln0_g, a.ln0_b, H1MB + (size_t)(m - M) * DM, nullptr, nullptr, lane);
        }
    }
    SEAM(5);

    if (IN(6)) {
        const int fr = lane & 15, fq = lane >> 4;
        for (int t = gw; t < 128; t += NGW) {
            const f32x4 acc = wave_gemm16(H1MB, DM, WPT + (size_t)t * 16 * DM, DM, DM, lane);
#pragma unroll
            for (int i = 0; i < 4; ++i) UM[(size_t)(4 * fq + i) * DM + t * 16 + fr] = acc[i];
        }
        pg8::Gemm g{H1B, WPT, DM, DM, DM, 0}; pg8::StaticOrder S; S.init(M, 2 * DM, G, bx);
        pg8::EpiSplit2 E{UB, Z1B};
        pg8::gemm_phase<pg8::EpiSplit2, pg8::StaticOrder, true>((LAS unsigned char*)lds, g, S, E);
    }
    SEAM(6);

    if (IN(7)) {
        for (int it = bx * 512 + tid; it < (M / 32) * 256; it += G * 512) {
            const int chunk = it & 255, run = it >> 8, c0 = chunk * 8, gq = c0 >> 9, w = 2 << gq; const float invw = 1.0f / (float)w;
            const int row0 = run * 32, b = row0 >> 12, i0 = row0 & 4095;
            const bf16_t* Ub = UB + (size_t)(b * SEQ) * DM + c0; const float* Um = UM + c0;
            float sum[8];
#pragma unroll
            for (int e = 0; e < 8; ++e) sum[e] = 0.f;
            for (int j = 1; j < w; ++j) { const int i = i0 - j;
                if (i >= 0) { const u32x4 q = *(const u32x4*)(Ub + (size_t)i * DM);
                    sum[0] += bflo(q.x); sum[1] += bfhi(q.x); sum[2] += bflo(q.y); sum[3] += bfhi(q.y); sum[4] += bflo(q.z); sum[5] += bfhi(q.z); sum[6] += bflo(q.w); sum[7] += bfhi(q.w); }
                else { const f32x4 p0 = *(const f32x4*)(Um + (size_t)(16 + i) * DM), p1 = *(const f32x4*)(Um + (size_t)(16 + i) * DM + 4);
                    sum[0] += p0[0]; sum[1] += p0[1]; sum[2] += p0[2]; sum[3] += p0[3]; sum[4] += p1[0]; sum[5] += p1[1]; sum[6] += p1[2]; sum[7] += p1[3]; } }
#pragma unroll 4
            for (int s = 0; s < 32; ++s) { const int i = i0 + s;
                const u32x4 q = *(const u32x4*)(Ub + (size_t)i * DM);
                float f[8] = {bflo(q.x), bfhi(q.x), bflo(q.y), bfhi(q.y), bflo(q.z), bfhi(q.z), bflo(q.w), bfhi(q.w)};
                float d[8];
#pragma unroll
                for (int e = 0; e < 8; ++e) { sum[e] += f[e]; d[e] = sum[e] * invw - f[e]; }
                u32x4 o; o.x = cvt_pk_bf16(d[0], d[1]); o.y = cvt_pk_bf16(d[2], d[3]); o.z = cvt_pk_bf16(d[4], d[5]); o.w = cvt_pk_bf16(d[6], d[7]);
                *(u32x4*)(DPB + (size_t)(row0 + s) * DM + c0) = o;
                const int io = i - w + 1;
                if (io >= 0) { const u32x4 r = *(const u32x4*)(Ub + (size_t)io * DM);
                    sum[0] -= bflo(r.x); sum[1] -= bfhi(r.x); sum[2] -= bflo(r.y); sum[3] -= bfhi(r.y); sum[4] -= bflo(r.z); sum[5] -= bfhi(r.z); sum[6] -= bflo(r.w); sum[7] -= bfhi(r.w); }
                else { const f32x4 p0 = *(const f32x4*)(Um + (size_t)(16 + io) * DM), p1 = *(const f32x4*)(Um + (size_t)(16 + io) * DM + 4);
                    sum[0] -= p0[0]; sum[1] -= p0[1]; sum[2] -= p0[2]; sum[3] -= p0[3]; sum[4] -= p1[0]; sum[5] -= p1[1]; sum[6] -= p1[2]; sum[7] -= p1[3]; } }
        }
    }
    SEAM(7);

    if (IN(8)) {
        pg8::Gemm g{DPB, WGT, DM, 512, 512, 2}; pg8::StaticOrder S; S.init(M, DM, G, bx);
        pg8::EpiGate E{Z1B, a.p_scale, EB};
        pg8::gemm_phase<pg8::EpiGate, pg8::StaticOrder, true>((LAS unsigned char*)lds, g, S, E);
    }
    SEAM(8);

    if (IN(9)) {
        pg8::Gemm g{EB, WO2T, DM, DM, DM, 0}; pg8::StaticOrder S; S.init(M, DM, G, bx);
        pg8::EpiT1 E{a.out, STATS, a.ln0_g, a.ln0_b};
        pg8::gemm_phase<pg8::EpiT1, pg8::StaticOrder, true>((LAS unsigned char*)lds, g, S, E);
    }
    SEAM(9);

    if (IN(10)) {
        for (int m = gw; m < M; m += NGW) ln_row(a.out + (size_t)m * DM, a.ln1_g, a.ln1_b, nullptr, a.out + (size_t)m * DM, nullptr, lane);
    }
#undef IN
#undef SEAM
}

extern "C" void kernel_launch(void* const* d_in, const int* in_sizes, int n_in, void* d_out, int out_size, void* d_ws, size_t ws_size, hipStream_t stream) {
    static int grid = 0;
    if (grid == 0) {
        if (n_in != 13 || in_sizes[0] != M * DM || out_size != M * DM || ws_size < WS_END) { fprintf(stderr, "kernel_launch: shape/workspace mismatch (n_in %d, in0 %d, out %d, ws %zu)\n", n_in, n_in > 0 ? in_sizes[0] : -1, out_size, ws_size); grid = -1; return; }
        int dev = 0, cus = 0, per_cu = 0;
        (void)hipGetDevice(&dev); (void)hipDeviceGetAttribute(&cus, hipDeviceAttributeMultiprocessorCount, dev);
        if (hipFuncSetAttribute((const void*)fwd, hipFuncAttributeMaxDynamicSharedMemorySize, LDS_BYTES) != hipSuccess) { fprintf(stderr, "kernel_launch: hipFuncSetAttribute failed\n"); grid = -1; return; }
        if (hipOccupancyMaxActiveBlocksPerMultiprocessor(&per_cu, (const void*)fwd, 512, LDS_BYTES) != hipSuccess || per_cu < 1) { fprintf(stderr, "kernel_launch: occupancy query says %d\n", per_cu); per_cu = 1; }
        (void)hipGetLastError();
        grid = cus * 1;
        if (grid <= 0) grid = 256;
    }
    if (grid < 0) return;
    Args a{};
    a.x = (const float*)d_in[0]; a.meta = (const float*)d_in[1]; a.w_in = (const float*)d_in[2]; a.b_f = (const float*)d_in[3]; a.w_out = (const float*)d_in[4];
    a.ln0_g = (const float*)d_in[5]; a.ln0_b = (const float*)d_in[6]; a.pw_in = (const float*)d_in[7]; a.pw_grp = (const float*)d_in[8]; a.p_scale = (const float*)d_in[9];
    a.pw_out = (const float*)d_in[10]; a.ln1_g = (const float*)d_in[11]; a.ln1_b = (const float*)d_in[12];
    a.out = (float*)d_out; a.ws = (unsigned char*)d_ws;
#if MK_N_LAUNCHES == 1
    a.ph_lo = 0; a.ph_hi = N_PHASES;
    void* args[] = {&a};
    hipError_t e = hipLaunchCooperativeKernel((const void*)fwd, dim3(grid), dim3(512), args, LDS_BYTES, stream);
    if (e != hipSuccess) fprintf(stderr, "kernel_launch: cooperative launch failed: %s (grid %d)\n", hipGetErrorString(e), grid);
#else
    for (int p = 0; p < N_PHASES; ++p) for (int rep = 0; rep < (p == PROBE_DUP ? 2 : 1); ++rep) { a.ph_lo = p; a.ph_hi = p + 1; hipLaunchKernelGGL(fwd, dim3(grid), dim3(512), LDS_BYTES, stream, a); }
#endif
}
```
